# Optimizing an MI355X kernel written in HIP

```python
import jax, jax.numpy as jnp
from jax import lax
import numpy as np

D_MODEL = 2048
BATCH = 4
SEQ = 4096
DEPTH = 2

CONV_WIDTH = D_MODEL // 2
CONV_KERNEL = 3
ATTN_HEAD_DIM = 128
ATTN_HEADS_PER_GROUP = D_MODEL // 512
ATTN_PATTERNS = ((128, 1), (512, 4), (2048, 16))
ATTN_HEADS = ATTN_HEADS_PER_GROUP * len(ATTN_PATTERNS)
ATTN_WIDTH = ATTN_HEADS * ATTN_HEAD_DIM
ATTN_OUT_WIDTH = ATTN_HEADS_PER_GROUP * ATTN_HEAD_DIM
ATTN_BLOCK = 128
ROPE_THETA = 500000.0
ROPE_DIM = ATTN_HEAD_DIM // 4
POOL_WINDOWS = (2, 4, 8, 16)
POOL_GROUPS = len(POOL_WINDOWS)
POOL_WIDTH = D_MODEL // 2
POOL_GROUP_DIM = POOL_WIDTH // POOL_GROUPS
N_BRANCHES = 3
D_FF = 7 * D_MODEL // 2
N_EXPERTS = 8
TOP_K = 2
EXPERT_BLOCK = 256
LN_EPS = 1e-5
DEEPNORM_ALPHA = (2.0 * DEPTH) ** 0.25
DEEPNORM_BETA = (8.0 * DEPTH) ** -0.25
NEG_INF = -1e30

_W_IN_PARTS = (CONV_WIDTH,) * 3 + (ATTN_WIDTH,) * 3 + (POOL_WIDTH,) + (N_BRANCHES * D_MODEL,)
W_IN_COLS = sum(_W_IN_PARTS)
W_IN_SPLITS = tuple(sum(_W_IN_PARTS[:i + 1]) for i in range(len(_W_IN_PARTS) - 1))

kernel_name = 'hybrid_conv_dilated_attn_pool_moe_deepnorm'


def layer_norm(x, g, b):
    xf = x.astype(jnp.float32)
    mu = jnp.mean(xf, axis=-1, keepdims=True)
    var = jnp.mean(jnp.square(xf - mu), axis=-1, keepdims=True)
    return ((xf - mu) * lax.rsqrt(var + LN_EPS)).astype(x.dtype) * g + b


def rotary_tables(seq, dtype):
    inv_freq = ROPE_THETA ** (-jnp.arange(0, ROPE_DIM, 2, dtype=jnp.float32) / ROPE_DIM)
    ang = jnp.arange(seq, dtype=jnp.float32)[:, None] * inv_freq[None, :]
    return jnp.cos(ang).astype(dtype), jnp.sin(ang).astype(dtype)


def partial_rotary(t, cos, sin):
    half = ROPE_DIM // 2
    r1, r2, rest = t[..., :half], t[..., half:ROPE_DIM], t[..., ROPE_DIM:]
    c = cos[None, :, None, :]
    s = sin[None, :, None, :]
    return jnp.concatenate([r1 * c - r2 * s, r2 * c + r1 * s, rest], axis=-1)


def dilated_window_attention(q, k, v, dilation, span):
    b, s, h, dh = q.shape
    L = s // dilation
    qb_len = min(ATTN_BLOCK, L)
    nb = -(-L // qb_len)
    lp = nb * qb_len
    n_keys = qb_len + span

    def to_sub(t):
        return t.reshape(b, L, dilation, h, dh).transpose(0, 2, 1, 3, 4)

    qs = jnp.pad(to_sub(q), ((0, 0), (0, 0), (0, lp - L), (0, 0), (0, 0)))
    kv_pad = ((0, 0), (0, 0), (span, lp - L), (0, 0), (0, 0))
    ks = jnp.pad(to_sub(k), kv_pad)
    vs = jnp.pad(to_sub(v), kv_pad)
    blk = jnp.arange(nb)
    idx = blk[:, None] * qb_len + jnp.arange(n_keys)[None, :]
    kb = ks[:, :, idx]
    vb = vs[:, :, idx]
    qb = qs.reshape(b, dilation, nb, qb_len, h, dh)
    scores = jnp.einsum('brnqhd,brnkhd->brnhqk', qb, kb).astype(jnp.float32) * (dh ** -0.5)
    a = jnp.arange(qb_len)[None, :, None]
    kk = jnp.arange(n_keys)[None, None, :]
    valid = (kk >= a) & (kk <= a + span) & (blk[:, None, None] * qb_len + kk >= span)
    scores = jnp.where(valid[None, None, :, None], scores, NEG_INF)
    lse = jax.nn.logsumexp(scores, axis=-1)
    probs = jnp.exp(scores - lse[..., None]).astype(v.dtype)
    out = jnp.einsum('brnhqk,brnkhd->brnqhd', probs, vb)
    out = out.reshape(b, dilation, lp, h, dh)[:, :, :L].transpose(0, 2, 1, 3, 4).reshape(b, s, h, dh)
    lse = lse.transpose(0, 1, 2, 4, 3).reshape(b, dilation, lp, h)[:, :, :L]
    lse = lse.transpose(0, 2, 1, 3).reshape(b, s, h)
    return out, lse


def multiscale_pool(u, pool_mix, pool_scale):
    b, s, _ = u.shape
    ug = u.reshape(b, s, POOL_GROUPS, POOL_GROUP_DIM)
    cs = jnp.cumsum(ug.astype(jnp.float32), axis=1)
    t = jnp.arange(1, s + 1, dtype=jnp.float32)
    means = []
    for gi, w in enumerate(POOL_WINDOWS):
        c = cs[:, :, gi]
        prev = jnp.pad(c, ((0, 0), (w, 0), (0, 0)))[:, :s]
        means.append((c - prev) / jnp.minimum(t, float(w))[None, :, None])
    pooled = jnp.stack(means, axis=2).astype(u.dtype) - ug
    mixed = jnp.einsum('bsgc,gce->bsge', pooled, pool_mix).reshape(b, s, POOL_WIDTH)
    return mixed * pool_scale


def hybrid_mixer(x, w_in, conv_w, w_br_conv, w_br_attn, pool_mix, pool_scale, w_br_pool, w_o, cos, sin):
    b, s, d = x.shape
    proj = jnp.einsum('bsd,dn->bsn', x, w_in)
    c_b, c_c, c_h, q, k, v, p_u, g = jnp.split(proj, W_IN_SPLITS, axis=-1)
    u = c_c * c_h
    u_pad = jnp.pad(u, ((0, 0), (CONV_KERNEL - 1, 0), (0, 0)))
    conv = u_pad[:, 0:s] * conv_w[0]
    for j in range(1, CONV_KERNEL):
        conv = conv + u_pad[:, j:j + s] * conv_w[j]
    y_a = jnp.einsum('bsc,cd->bsd', c_b * conv, w_br_conv)
    q = partial_rotary(q.reshape(b, s, ATTN_HEADS, ATTN_HEAD_DIM), cos, sin)
    k = partial_rotary(k.reshape(b, s, ATTN_HEADS, ATTN_HEAD_DIM), cos, sin)
    v = v.reshape(b, s, ATTN_HEADS, ATTN_HEAD_DIM)
    outs, lses = [], []
    for gi, (window, dilation) in enumerate(ATTN_PATTERNS):
        hs = slice(gi * ATTN_HEADS_PER_GROUP, (gi + 1) * ATTN_HEADS_PER_GROUP)
        o, l = dilated_window_attention(q[:, :, hs], k[:, :, hs], v[:, :, hs], dilation, window // dilation)
        outs.append(o)
        lses.append(l)
    wts = jax.nn.softmax(jnp.stack(lses, axis=0), axis=0)
    attn = jnp.sum(wts[..., None] * jnp.stack(outs, axis=0).astype(jnp.float32), axis=0).astype(x.dtype)
    y_b = jnp.einsum('bsc,cd->bsd', attn.reshape(b, s, ATTN_OUT_WIDTH), w_br_attn)
    y_c = jnp.einsum('bsc,cd->bsd', multiscale_pool(p_u, pool_mix, pool_scale), w_br_pool)
    gates = jax.nn.sigmoid(g.astype(jnp.float32)).astype(x.dtype).reshape(b, s, N_BRANCHES, d)
    merged = gates[:, :, 0] * y_a + gates[:, :, 1] * y_b + gates[:, :, 2] * y_c
    return jnp.einsum('bsd,de->bse', merged, w_o)


def swiglu(x, w_gate, w_up, w_down):
    h = jax.nn.silu(jnp.einsum('bsd,df->bsf', x, w_gate)) * jnp.einsum('bsd,df->bsf', x, w_up)
    return jnp.einsum('bsf,fd->bsd', h, w_down)


def moe_swiglu(x, w_router, w_gate, w_up, w_down):
    b, s, d = x.shape
    n_tok = b * s
    n_assign = n_tok * TOP_K
    xf = x.reshape(n_tok, d)
    logits = jnp.einsum('nd,de->ne', xf, w_router).astype(jnp.float32)
    top_val, top_idx = lax.top_k(logits, TOP_K)
    top_gate = jax.nn.softmax(top_val, axis=-1)
    exp_flat = top_idx.reshape(-1)
    tok_flat = jnp.arange(n_assign, dtype=jnp.int32) // TOP_K
    gate_flat = top_gate.reshape(-1)
    order = jnp.argsort(exp_flat)
    exp_sorted = exp_flat[order]
    tok_sorted = tok_flat[order]
    gate_sorted = gate_flat[order]
    counts = jnp.zeros((N_EXPERTS,), jnp.int32).at[exp_flat].add(1)
    padded = (counts + EXPERT_BLOCK - 1) // EXPERT_BLOCK * EXPERT_BLOCK
    start = jnp.cumsum(counts) - counts
    pend = jnp.cumsum(padded)
    pstart = pend - padded
    rank = jnp.arange(n_assign, dtype=jnp.int32) - start[exp_sorted]
    dest = pstart[exp_sorted] + rank
    cap = -(-n_assign // EXPERT_BLOCK) * EXPERT_BLOCK + N_EXPERTS * EXPERT_BLOCK
    n_blk = cap // EXPERT_BLOCK
    buf_tok = jnp.zeros((cap,), jnp.int32).at[dest].set(tok_sorted)
    buf_gate = jnp.zeros((cap,), jnp.float32).at[dest].set(gate_sorted)
    blk_start = jnp.arange(n_blk, dtype=jnp.int32) * EXPERT_BLOCK
    blk_exp = jnp.clip(jnp.searchsorted(pend, blk_start, side='right'), 0, N_EXPERTS - 1)
    xs = xf[buf_tok].reshape(n_blk, EXPERT_BLOCK, d)

    def expert_block(args):
        xb, e = args
        h = jax.nn.silu(xb @ w_gate[e]) * (xb @ w_up[e])
        return h @ w_down[e]

    ys = lax.map(expert_block, (xs, blk_exp)).reshape(cap, d)
    ys = (ys.astype(jnp.float32) * buf_gate[:, None]).astype(x.dtype)
    out = jnp.zeros((n_tok, d), x.dtype).at[buf_tok].add(ys)
    return out.reshape(b, s, d)


def _normal(key, shape, scale):
    return jax.random.normal(key, shape, jnp.float32) * scale


def setup_inputs(seed: int = 0) -> dict:
    key = jax.random.key(seed)
    keys = jax.random.split(key, DEPTH + 1)
    params = {'x': jax.random.normal(keys[0], (BATCH, SEQ, D_MODEL), jnp.float32)}
    for layer in range(DEPTH):
        ks = jax.random.split(keys[layer + 1], 16)
        p = 'l%d_' % layer
        params[p + 'w_in'] = _normal(ks[0], (D_MODEL, W_IN_COLS), D_MODEL ** -0.5)
        params[p + 'conv_w'] = _normal(ks[1], (CONV_KERNEL, CONV_WIDTH), CONV_KERNEL ** -0.5)
        params[p + 'w_br_conv'] = _normal(ks[2], (CONV_WIDTH, D_MODEL), CONV_WIDTH ** -0.5)
        params[p + 'w_br_attn'] = _normal(ks[3], (ATTN_OUT_WIDTH, D_MODEL), ATTN_OUT_WIDTH ** -0.5)
        params[p + 'pool_mix'] = _normal(ks[4], (POOL_GROUPS, POOL_GROUP_DIM, POOL_GROUP_DIM), POOL_GROUP_DIM ** -0.5)
        params[p + 'pool_scale'] = 1.0 + _normal(ks[5], (POOL_WIDTH,), 0.1)
        params[p + 'w_br_pool'] = _normal(ks[6], (POOL_WIDTH, D_MODEL), POOL_WIDTH ** -0.5)
        params[p + 'w_o'] = _normal(ks[7], (D_MODEL, D_MODEL), D_MODEL ** -0.5 * DEEPNORM_BETA)
        params[p + 'ln1_g'] = 1.0 + _normal(ks[8], (D_MODEL,), 0.02)
        params[p + 'ln1_b'] = _normal(ks[9], (D_MODEL,), 0.02)
        if layer % 2 == 0:
            params[p + 'ffn_gate'] = _normal(ks[10], (D_MODEL, D_FF), D_MODEL ** -0.5)
            params[p + 'ffn_up'] = _normal(ks[11], (D_MODEL, D_FF), D_MODEL ** -0.5)
            params[p + 'ffn_down'] = _normal(ks[12], (D_FF, D_MODEL), D_FF ** -0.5 * DEEPNORM_BETA)
        else:
            params[p + 'router'] = _normal(ks[13], (D_MODEL, N_EXPERTS), D_MODEL ** -0.5)
            params[p + 'exp_gate'] = _normal(ks[10], (N_EXPERTS, D_MODEL, D_FF), D_MODEL ** -0.5)
            params[p + 'exp_up'] = _normal(ks[11], (N_EXPERTS, D_MODEL, D_FF), D_MODEL ** -0.5)
            params[p + 'exp_down'] = _normal(ks[12], (N_EXPERTS, D_FF, D_MODEL), D_FF ** -0.5 * DEEPNORM_BETA)
        params[p + 'ln2_g'] = 1.0 + _normal(ks[14], (D_MODEL,), 0.02)
        params[p + 'ln2_b'] = _normal(ks[15], (D_MODEL,), 0.02)
    return params


def reference(x,
              l0_w_in, l0_conv_w, l0_w_br_conv, l0_w_br_attn, l0_pool_mix, l0_pool_scale, l0_w_br_pool, l0_w_o,
              l0_ln1_g, l0_ln1_b, l0_ffn_gate, l0_ffn_up, l0_ffn_down, l0_ln2_g, l0_ln2_b,
              l1_w_in, l1_conv_w, l1_w_br_conv, l1_w_br_attn, l1_pool_mix, l1_pool_scale, l1_w_br_pool, l1_w_o,
              l1_ln1_g, l1_ln1_b, l1_router, l1_exp_gate, l1_exp_up, l1_exp_down, l1_ln2_g, l1_ln2_b):
    mixers = ((l0_w_in, l0_conv_w, l0_w_br_conv, l0_w_br_attn, l0_pool_mix, l0_pool_scale, l0_w_br_pool, l0_w_o),
              (l1_w_in, l1_conv_w, l1_w_br_conv, l1_w_br_attn, l1_pool_mix, l1_pool_scale, l1_w_br_pool, l1_w_o))
    norms = ((l0_ln1_g, l0_ln1_b, l0_ln2_g, l0_ln2_b), (l1_ln1_g, l1_ln1_b, l1_ln2_g, l1_ln2_b))
    ffns = ((l0_ffn_gate, l0_ffn_up, l0_ffn_down), (l1_router, l1_exp_gate, l1_exp_up, l1_exp_down))
    cos, sin = rotary_tables(x.shape[1], x.dtype)
    for layer in range(DEPTH):
        ln1_g, ln1_b, ln2_g, ln2_b = norms[layer]
        mix = hybrid_mixer(x, *mixers[layer], cos, sin)
        x = layer_norm(DEEPNORM_ALPHA * x + mix, ln1_g, ln1_b)
        if layer % 2 == 0:
            f = swiglu(x, *ffns[layer])
        else:
            f = moe_swiglu(x, *ffns[layer])
        x = layer_norm(DEEPNORM_ALPHA * x + f, ln2_g, ln2_b)
    return x
```

```cpp
#include <hip/hip_runtime.h>
#include <cstdio>
#include <cstdint>
#include <cmath>

#ifndef MK_N_LAUNCHES
#define MK_N_LAUNCHES 1
#endif

#ifndef PH_MASK
#define PH_MASK 0xFFFFF
#endif
#ifndef GEMM_SP2
#define GEMM_SP2 true
#endif
#define PH_ON(k) (((PH_MASK) >> (k)) & 1)
#define GAS __attribute__((address_space(1)))
#define LAS __attribute__((address_space(3)))
typedef unsigned short bf16;
typedef short bf16x8 __attribute__((ext_vector_type(8)));
typedef short s16x4 __attribute__((ext_vector_type(4)));
typedef float f32x4 __attribute__((ext_vector_type(4)));
typedef float f32x2 __attribute__((ext_vector_type(2)));
typedef unsigned u32x4 __attribute__((ext_vector_type(4)));
typedef unsigned u32x2 __attribute__((ext_vector_type(2)));
typedef GAS unsigned gu32;

constexpr int D = 2048, SEQ = 4096, BATCH = 4, M = BATCH * SEQ;
constexpr int NIN = 14848;
constexpr int C_CB = 0, C_CC = 1024, C_CH = 2048, C_Q = 3072, C_K = 4608, C_V = 6144, C_PU = 7680, C_G = 8704;
constexpr int FF = 7168, NEXP = 8;
constexpr int KBR = 2560;
constexpr float LN_EPS = 1e-5f;
constexpr float ALPHA = 1.41421356237309515f;
constexpr int MOE_MAXT = 136;

constexpr size_t MiB = 1u << 20;
constexpr size_t WS_CTL = 0, CTL_ZERO_BYTES = 1 * MiB;
constexpr size_t WS_ROT = 1 * MiB;
constexpr size_t WS_LIST = 2 * MiB;
constexpr size_t WS_INFO = WS_LIST + 512 * 1024;
constexpr size_t WS_LSE = 4 * MiB;
constexpr size_t WS_WL = 5 * MiB, WL_STRIDE = 77 * MiB;
constexpr size_t WL_WIN = 0, WL_WBR = 58 * MiB, WL_WO = 68 * MiB, WL_PM = 76 * MiB;
constexpr size_t WS_FFN0 = WS_WL + 2 * WL_STRIDE;
constexpr size_t FFN_WGU = 0, FFN_WD = 56 * MiB, FFN_STRIDE = 84 * MiB;
constexpr size_t WS_MOE = WS_FFN0 + FFN_STRIDE;
constexpr size_t WS_XB = WS_MOE + 8 * FFN_STRIDE;
constexpr size_t WS_BIG = WS_XB + 64 * MiB;
constexpr size_t BIG_PROJ = 0, BIG_ABR = 464 * MiB, BIG_MRG = 544 * MiB, BIG_BYTES = 608 * MiB;
constexpr size_t WS_ATT = WS_BIG + BIG_BYTES;
constexpr size_t WS_Y = WS_ATT + 48 * MiB;
constexpr size_t Y_SCR = 0, Y_POOLED = 64 * MiB;
constexpr size_t WS_END = WS_Y + 136 * MiB;
static_assert((size_t)MOE_MAXT * 256 * FF * 2 <= BIG_BYTES, "h overlay");
constexpr int CW_TMO = 0, CW_CODE = 1, CW_BAR = 4096, CW_CNT = 8192;

constexpr int RING_BYTES = 131072, LDSCTL_OFF = RING_BYTES, MISC_OFF = LDSCTL_OFF + 320, TAB_OFF = LDSCTL_OFF + 512;
constexpr int LDS_BYTES = 147456;

#define RLX_AGENT __ATOMIC_RELAXED, __HIP_MEMORY_SCOPE_AGENT
#define LDS_WAIT() asm volatile("s_waitcnt lgkmcnt(0)" ::: "memory")
#define VM_WAIT() asm volatile("s_waitcnt vmcnt(0)" ::: "memory")
__device__ __forceinline__ unsigned cvt_pk_bf16(float lo, float hi) { unsigned r; asm volatile("v_cvt_pk_bf16_f32 %0, %1, %2" : "=v"(r) : "v"(lo), "v"(hi)); return r; }
__device__ __forceinline__ float bflo(unsigned w) { return __uint_as_float(w << 16); }
__device__ __forceinline__ float bfhi(unsigned w) { return __uint_as_float(w & 0xffff0000u); }
__device__ __forceinline__ void unpack8(const u32x4 w, float (&f)[8]) { f[0] = bflo(w.x); f[1] = bfhi(w.x); f[2] = bflo(w.y); f[3] = bfhi(w.y); f[4] = bflo(w.z); f[5] = bfhi(w.z); f[6] = bflo(w.w); f[7] = bfhi(w.w); }
__device__ __forceinline__ u32x4 pack8(const float (&f)[8]) { u32x4 w; w.x = cvt_pk_bf16(f[0], f[1]); w.y = cvt_pk_bf16(f[2], f[3]); w.z = cvt_pk_bf16(f[4], f[5]); w.w = cvt_pk_bf16(f[6], f[7]); return w; }
__device__ __forceinline__ float fast_sigmoid(float x) { return __builtin_amdgcn_rcpf(1.0f + __builtin_amdgcn_exp2f(-1.4426950408889634f * x)); }
__device__ __forceinline__ float wave_sum(float v) {
#pragma unroll
    for (int o = 1; o < 64; o <<= 1) v += __shfl_xor(v, o);
    return v;
}

namespace pg8 {
#define PG8_LAS __attribute__((address_space(3)))
constexpr int BM = 256, BK = 64, HALF = 128, HTB = HALF * BK * 2, STAGE_BYTES = 8 * HTB;
__host__ __device__ __forceinline__ int lds_byte(int r, int c) { const int st = (r >> 4) * 2 + (c >> 5), rr = r & 15, cc = c & 31, ob = rr * 64 + cc * 2; return st * 1024 + (ob ^ (((ob >> 9) & 1) << 5)); }
__host__ __device__ __forceinline__ void stage_rc(int b, int& R, int& C) { const int st = b / 1024, sb = b % 1024, swz = sb ^ (((sb >> 9) & 1) << 5); R = (st >> 1) * 16 + swz / 64; C = (st & 1) * 32 + (swz % 64) / 2; }
__host__ __device__ __forceinline__ int perm32(int rho) { const int n = rho >> 4, i = rho & 15; return 8 * (i >> 2) + 4 * n + (i & 3); }

struct Unit { const char* A; const char* B; int nt; int pm, pn, aux; };

template <class Epi, class Sched, bool GATHER, bool ALIGN_EPI, bool SP2>
__device__ __forceinline__ void gemm_phase(PG8_LAS unsigned char* lds, const int lda, const int ldb, const Sched& S, const Epi& E) {
    int tid_ = threadIdx.x; asm volatile("" : "+v"(tid_));
    const int tid = tid_, wid = __builtin_amdgcn_readfirstlane(tid >> 6), lane = tid & 63, wr = wid >> 2, wc = wid & 3, fr = lane & 15, fq = lane >> 4;
    unsigned voffB[2], vA[2][2], vN[2][2]; int RA[2], CA[2];
#pragma unroll
    for (int i = 0; i < 2; ++i) { int R, C; stage_rc(tid * 16 + i * 8192, R, C); const int Rb = Epi::PERM ? ((R & ~31) + perm32(R & 31)) : R;
        RA[i] = R; CA[i] = C; voffB[i] = (unsigned)(Rb * ldb + C) * 2u;
#pragma unroll
        for (int h = 0; h < 2; ++h) { vA[h][i] = (unsigned)((h * HALF + R) * lda + C) * 2u; vN[h][i] = vA[h][i]; } }
    const size_t kstep = (size_t)(BK * 2);
    const size_t hstepB = (size_t)HALF * ldb * 2;
    const unsigned ldsw = (unsigned)wid * 1024u;
    const int aoff = lds_byte(wr * 64 + fr, fq * 8), boff = lds_byte(wc * 32 + fr, fq * 8);
#define PG8_SA(b, h) (((b) * 2 + (h)) * HTB)
#define PG8_SB(b, h) ((4 + (b) * 2 + (h)) * HTB)
#define PG8_STAGE_B(bufoff, gbase) do { _Pragma("unroll") for (int _i = 0; _i < 2; ++_i) \
        __builtin_amdgcn_global_load_lds((const unsigned*)((const char*)(gbase) + voffB[_i]), (PG8_LAS unsigned*)(lds + (bufoff) + ldsw + _i * 8192), 16, 0, 0); } while (0)
#define PG8_STAGE_A(bufoff, gbase, vo) do { _Pragma("unroll") for (int _i = 0; _i < 2; ++_i) \
        __builtin_amdgcn_global_load_lds((const unsigned*)((const char*)(gbase) + (vo)[_i]), (PG8_LAS unsigned*)(lds + (bufoff) + ldsw + _i * 8192), 16, 0, 0); } while (0)
#define PG8_LDA(dst, b, h) do { _Pragma("unroll") for (int m = 0; m < 4; ++m) _Pragma("unroll") for (int k = 0; k < 2; ++k) dst[m][k] = *(const PG8_LAS bf16x8*)(lds + PG8_SA(b, h) + aoff + m * 2048 + k * 1024); } while (0)
#define PG8_LDB(dst, b, h) do { _Pragma("unroll") for (int n = 0; n < 2; ++n) _Pragma("unroll") for (int k = 0; k < 2; ++k) dst[n][k] = *(const PG8_LAS bf16x8*)(lds + PG8_SB(b, h) + boff + n * 2048 + k * 1024); } while (0)
#define PG8_MMA(ai, bj, At, Bt) do { __builtin_amdgcn_s_setprio(1); _Pragma("unroll") for (int m = 0; m < 4; ++m) _Pragma("unroll") for (int n = 0; n < 2; ++n) _Pragma("unroll") for (int k = 0; k < 2; ++k) \
        acc[ai][bj][m][n] = __builtin_amdgcn_mfma_f32_16x16x32_bf16(Bt[n][k], At[m][k], acc[ai][bj][m][n], 0, 0, 0); __builtin_amdgcn_s_setprio(0); } while (0)
#define PG8_WAIT_V(n) asm volatile("s_waitcnt vmcnt(" #n ")" ::: "memory")
#define PG8_WAIT_L(n) asm volatile("s_waitcnt lgkmcnt(" #n ")" ::: "memory")
#define PG8_BAR __builtin_amdgcn_s_barrier()
#define PG8_SCHED __builtin_amdgcn_sched_barrier(0)
#define PG8_ROWS(dst, u) do { _Pragma("unroll") for (int _h = 0; _h < 2; ++_h) _Pragma("unroll") for (int _i = 0; _i < 2; ++_i) dst[_h][_i] = S.row_off(u, _h * HALF + RA[_i]) + (unsigned)CA[_i] * 2u; } while (0)
    Unit cur, nxt; int ui = 0;
    if (!S.next(0, cur)) return;
    f32x4 acc[2][2][4][2];
#pragma unroll
    for (int a = 0; a < 2; ++a)
#pragma unroll
        for (int b = 0; b < 2; ++b)
#pragma unroll
            for (int m = 0; m < 4; ++m)
#pragma unroll
                for (int n = 0; n < 2; ++n) acc[a][b][m][n] = (f32x4){0.f, 0.f, 0.f, 0.f};
    bf16x8 At[4][2], B0[2][2], B1[2][2];
    const char* cA = cur.A; const char* cB = cur.B; int nt = cur.nt; asm volatile("" : "+s"(nt));
    if constexpr (GATHER) { PG8_ROWS(vA, cur); }
    S.a_ready(cur);
    if constexpr (SP2) {
        PG8_STAGE_B(PG8_SB(0, 0), cB); PG8_STAGE_B(PG8_SB(0, 1), cB + hstepB); PG8_STAGE_A(PG8_SA(0, 0), cA, vA[0]); PG8_STAGE_A(PG8_SA(0, 1), cA, vA[1]);
        if (wr == 1) PG8_BAR;
        PG8_WAIT_V(2); PG8_BAR;
        PG8_STAGE_B(PG8_SB(1, 0), cB + kstep); PG8_STAGE_A(PG8_SA(1, 0), cA + kstep, vA[0]); PG8_STAGE_B(PG8_SB(1, 1), cB + hstepB + kstep);
        PG8_WAIT_V(6); PG8_BAR;
    } else {
        PG8_STAGE_B(PG8_SB(0, 0), cB); PG8_STAGE_A(PG8_SA(0, 0), cA, vA[0]); PG8_STAGE_B(PG8_SB(0, 1), cB + hstepB); PG8_STAGE_A(PG8_SA(0, 1), cA, vA[1]);
        if (wr == 1) PG8_BAR;
        PG8_WAIT_V(4); PG8_BAR;
        PG8_STAGE_B(PG8_SB(1, 0), cB + kstep); PG8_STAGE_A(PG8_SA(1, 0), cA + kstep, vA[0]); PG8_STAGE_B(PG8_SB(1, 1), cB + hstepB + kstep);
        PG8_WAIT_V(6); PG8_BAR;
    }
    for (;;) {
        const bool has_next = S.next(ui + 1, nxt);
        const char* nA = has_next ? nxt.A : cA; const char* nB = has_next ? nxt.B : cB;
        if constexpr (GATHER) { if (has_next) { PG8_ROWS(vN, nxt); } }
#pragma clang loop unroll(disable)
        for (int t = 0; t < nt; t += 2) {
            const bool last = (t == nt - 2);
            const char* a1 = cA + (size_t)(t + 1) * kstep;
            const char* a2 = last ? nA : cA + (size_t)(t + 2) * kstep; const char* b2 = last ? nB : cB + (size_t)(t + 2) * kstep;
            const char* a3 = a2 + kstep; const char* b3 = b2 + kstep;
            unsigned v2[2][2];
#pragma unroll
            for (int h = 0; h < 2; ++h)
#pragma unroll
                for (int i = 0; i < 2; ++i) v2[h][i] = (GATHER && last) ? vN[h][i] : vA[h][i];
            if (last && has_next) S.a_ready(nxt);
            if constexpr (SP2) {
            PG8_LDB(B0, 0, 0); PG8_LDB(B1, 0, 1); PG8_SCHED; PG8_LDA(At, 0, 0); PG8_STAGE_A(PG8_SA(1, 1), a1, vA[1]);
            PG8_WAIT_V(8); PG8_WAIT_L(0); PG8_BAR; PG8_MMA(0, 0, At, B0); PG8_MMA(0, 1, At, B1); PG8_BAR; PG8_SCHED;
            PG8_LDA(At, 0, 1); PG8_STAGE_B(PG8_SB(0, 0), b2); PG8_STAGE_B(PG8_SB(0, 1), b2 + hstepB); PG8_STAGE_A(PG8_SA(0, 0), a2, v2[0]);
            PG8_WAIT_V(8); PG8_WAIT_L(0); PG8_BAR; PG8_MMA(1, 0, At, B0); PG8_MMA(1, 1, At, B1); PG8_BAR; PG8_SCHED;
            PG8_LDB(B0, 1, 0); PG8_LDB(B1, 1, 1); PG8_SCHED; PG8_LDA(At, 1, 0); PG8_STAGE_A(PG8_SA(0, 1), a2, v2[1]);
            PG8_WAIT_V(8); PG8_WAIT_L(0); PG8_BAR; PG8_MMA(0, 0, At, B0); PG8_MMA(0, 1, At, B1); PG8_BAR; PG8_SCHED;
            PG8_LDA(At, 1, 1); PG8_STAGE_B(PG8_SB(1, 0), b3); PG8_STAGE_B(PG8_SB(1, 1), b3 + hstepB); PG8_STAGE_A(PG8_SA(1, 0), a3, v2[0]);
            PG8_WAIT_V(8); PG8_WAIT_L(0); PG8_BAR; PG8_MMA(1, 0, At, B0); PG8_MMA(1, 1, At, B1); PG8_BAR; PG8_SCHED;
            } else {
            PG8_LDB(B0, 0, 0); PG8_SCHED; PG8_LDA(At, 0, 0); PG8_STAGE_A(PG8_SA(1, 1), a1, vA[1]);
            PG8_WAIT_L(8); PG8_BAR; PG8_WAIT_L(0); PG8_MMA(0, 0, At, B0); PG8_BAR; PG8_SCHED;
            PG8_LDB(B1, 0, 1); PG8_STAGE_B(PG8_SB(0, 0), b2);
            PG8_BAR; PG8_WAIT_L(0); PG8_MMA(0, 1, At, B1); PG8_BAR;
            PG8_LDA(At, 0, 1); PG8_STAGE_A(PG8_SA(0, 0), a2, v2[0]);
            PG8_BAR; PG8_WAIT_L(0); PG8_MMA(1, 0, At, B0); PG8_BAR; PG8_SCHED;
            PG8_STAGE_B(PG8_SB(0, 1), b2 + hstepB);
            PG8_WAIT_V(6); PG8_BAR; PG8_MMA(1, 1, At, B1); PG8_BAR;
            PG8_LDB(B0, 1, 0); PG8_SCHED; PG8_LDA(At, 1, 0); PG8_STAGE_A(PG8_SA(0, 1), a2, v2[1]);
            PG8_WAIT_L(8); PG8_BAR; PG8_WAIT_L(0); PG8_MMA(0, 0, At, B0); PG8_BAR; PG8_SCHED;
            PG8_LDB(B1, 1, 1); PG8_STAGE_B(PG8_SB(1, 0), b3);
            PG8_BAR; PG8_WAIT_L(0); PG8_MMA(0, 1, At, B1); PG8_BAR;
            PG8_LDA(At, 1, 1); PG8_STAGE_A(PG8_SA(1, 0), a3, v2[0]);
            PG8_BAR; PG8_WAIT_L(0); PG8_MMA(1, 0, At, B0); PG8_BAR; PG8_SCHED;
            PG8_STAGE_B(PG8_SB(1, 1), b3 + hstepB);
            PG8_WAIT_V(6); PG8_BAR; PG8_MMA(1, 1, At, B1); PG8_BAR;
            }
        }
        if constexpr (ALIGN_EPI) { if (wr == 0) PG8_BAR; }
        E(acc, cur, wr, wc, fr, fq);
        if (!has_next) break;
#pragma unroll
        for (int a = 0; a < 2; ++a)
#pragma unroll
            for (int b = 0; b < 2; ++b)
#pragma unroll
                for (int m = 0; m < 4; ++m)
#pragma unroll
                    for (int n = 0; n < 2; ++n) acc[a][b][m][n] = (f32x4){0.f, 0.f, 0.f, 0.f};
        cur = nxt; cA = nA; cB = nB; nt = nxt.nt; ++ui;
        if constexpr (GATHER) {
#pragma unroll
            for (int h = 0; h < 2; ++h)
#pragma unroll
                for (int i = 0; i < 2; ++i) vA[h][i] = vN[h][i];
        }
        if constexpr (ALIGN_EPI) { if (wr == 1) PG8_BAR; }
    }
    PG8_WAIT_V(0);
    if constexpr (!ALIGN_EPI) { if (wr == 0) PG8_BAR; }
    PG8_BAR;
#undef PG8_SA
#undef PG8_SB
#undef PG8_STAGE_A
#undef PG8_STAGE_B
#undef PG8_LDA
#undef PG8_LDB
#undef PG8_MMA
#undef PG8_WAIT_V
#undef PG8_WAIT_L
#undef PG8_BAR
#undef PG8_SCHED
#undef PG8_ROWS
}

__device__ __forceinline__ bool tile_of(int L, int nM, int nN, int& pm, int& pn) {
    const int nwg = nM * nN; if (L >= nwg) return false;
    int wgid = L; { const int q = nwg / 8, r = nwg % 8, xcd = wgid % 8, off = wgid / 8; wgid = (xcd < r ? xcd * (q + 1) : r * (q + 1) + (xcd - r) * q) + off; }
    const int nig = 8 * nN, gid = wgid / nig, fm = gid * 8, gsz = (nM - fm) < 8 ? (nM - fm) : 8;
    pm = fm + ((wgid % nig) % gsz); pn = (wgid % nig) / gsz; return true;
}
}

#define XB_TMO      128
#define XB_XCNT(j)  (256  + 64 * (j))
#define XB_XSUB(j)  (1280 + 64 * (j))
#define XB_XGEN(j)  (2304 + 64 * (j))
#define XB_TOP      3328
#define XB_TOPGEN   3392
#define XCD_BAR_WORDS 3456
#define XB_SPIN_CAP (1u << 18)
__device__ __forceinline__ unsigned xb_ld(unsigned* p)              { return __hip_atomic_load(p, __ATOMIC_RELAXED, __HIP_MEMORY_SCOPE_AGENT); }
__device__ __forceinline__ unsigned xb_add(unsigned* p, unsigned v) { return __hip_atomic_fetch_add(p, v, __ATOMIC_RELAXED, __HIP_MEMORY_SCOPE_AGENT); }
__device__ __forceinline__ unsigned xb_xcc_id() { return (unsigned)__builtin_amdgcn_s_getreg((3 << 11) | 20) & 0xFu; }
#define XB_SPIN(cond, bar) do { unsigned _sp = 0; while (cond) { __builtin_amdgcn_s_sleep(1); \
    if ((++_sp & 255u) == 0u) { if (xb_ld(&(bar)[XB_TMO])) break; if (_sp > XB_SPIN_CAP) { atomicAdd(&(bar)[XB_TMO], 1u); break; } } } } while (0)
struct XcdBarrier { unsigned* bar; unsigned x; volatile LAS unsigned* st; };
__device__ __forceinline__ XcdBarrier xcd_barrier_post(unsigned* bar, volatile LAS unsigned* st) {
    XcdBarrier b; b.bar = bar; b.x = xb_xcc_id(); b.st = st;
    if (threadIdx.x == 0) (void)xb_add(&bar[XB_XCNT(b.x)], 1u);
    return b;
}
__device__ __forceinline__ void xcd_barrier_complete(unsigned* bar, unsigned x, unsigned& nloc, unsigned& nx) {
    const unsigned G = gridDim.x * gridDim.y * gridDim.z;
    unsigned sum, cnt, mine, sp = 0u;
    for (;;) {
        sum = 0u; cnt = 0u; mine = 0u;
#pragma unroll
        for (unsigned j = 0; j < 16; ++j) { const unsigned c = xb_ld(&bar[XB_XCNT(j)]); sum += c; cnt += (c > 0u) ? 1u : 0u; mine = (j == x) ? c : mine; }
        if (sum == G) break;
        __builtin_amdgcn_s_sleep(1);
        if ((++sp & 255u) == 0u) { if (xb_ld(&bar[XB_TMO])) break; if (sp > XB_SPIN_CAP) { atomicAdd(&bar[XB_TMO], 1u); break; } }
    }
    nloc = mine > 0u ? mine : 1u; nx = cnt > 0u ? cnt : 1u;
}
__device__ __forceinline__ void xcd_barrier(const XcdBarrier& b) {
    asm volatile("s_waitcnt vmcnt(0)" ::: "memory");
    __syncthreads();
    if (threadIdx.x == 0) {
        unsigned* bar = b.bar;
        __builtin_amdgcn_s_waitcnt(0);
        unsigned nloc = b.st[0], nx = b.st[1];
        if (nloc == 0u) { xcd_barrier_complete(bar, b.x, nloc, nx); b.st[0] = nloc; b.st[1] = nx; }
        const unsigned old = xb_add(&bar[XB_XSUB(b.x)], 1u);
        const unsigned gen = old / nloc;
        if (old + 1u == (gen + 1u) * nloc) {
            __builtin_amdgcn_fence(__ATOMIC_RELEASE, "agent");
            asm volatile("s_waitcnt vmcnt(0)" ::: "memory");
            const unsigned og = xb_add(&bar[XB_TOP], 1u);
            const unsigned tg = og / nx;
            if (og + 1u == (tg + 1u) * nx) xb_add(&bar[XB_TOPGEN], 1u);
            else XB_SPIN(xb_ld(&bar[XB_TOPGEN]) == tg, bar);
            __builtin_amdgcn_fence(__ATOMIC_ACQUIRE, "agent");
            xb_add(&bar[XB_XGEN(b.x)], 1u);
            asm volatile("s_waitcnt vmcnt(0)" ::: "memory");
        } else {
            XB_SPIN(xb_ld(&bar[XB_XGEN(b.x)]) == gen, bar);
            __builtin_amdgcn_fence(__ATOMIC_ACQUIRE, "agent");
            asm volatile("s_waitcnt vmcnt(0)" ::: "memory");
        }
    }
    __syncthreads();
}

struct Args { const float* in[32]; float* out; unsigned char* ws; float inv_freq[16]; int ph_lo, ph_hi, pad0, pad1; };

using pg8::Unit;
struct DenseSched {
    const char* A; const char* B; int nM, nN, nt, G, c; size_t strideA, strideB;
    __device__ __forceinline__ bool next(int i, Unit& u) const { int pm, pn; if (!pg8::tile_of(i * G + c, nM, nN, pm, pn)) return false;
        u.A = A + (size_t)pm * strideA; u.B = B + (size_t)pn * strideB; u.nt = nt; u.pm = pm; u.pn = pn; u.aux = 0; return true; }
    __device__ __forceinline__ void a_ready(const Unit&) const {}
    __device__ __forceinline__ unsigned row_off(const Unit&, int) const { return 0u; }
};
struct BranchSched {
    const char* A; const char* B; int G, c;
    __device__ __forceinline__ bool next(int i, Unit& u) const { const int ti = i / 3, seg = i - 3 * ti; int pm, pn; if (!pg8::tile_of(ti * G + c, M / 256, D / 256, pm, pn)) return false;
        const int koff = seg == 0 ? 0 : (seg == 1 ? 1024 : 1536);
        u.A = A + ((size_t)pm * 256 * KBR + koff) * 2; u.B = B + ((size_t)pn * 256 * KBR + koff) * 2; u.nt = seg == 1 ? 8 : 16; u.pm = pm; u.pn = pn; u.aux = seg; return true; }
    __device__ __forceinline__ void a_ready(const Unit&) const {}
    __device__ __forceinline__ unsigned row_off(const Unit&, int) const { return 0u; }
};
struct PoolMixSched {
    const char* A; const char* B; int G, c;
    __device__ __forceinline__ bool next(int i, Unit& u) const { const int L = i * G + c; if (L >= 256) return false; const int pm = L >> 2, g = L & 3;
        u.A = A + ((size_t)pm * 256 * 1024 + g * 256) * 2; u.B = B + (size_t)g * 256 * 2; u.nt = 4; u.pm = pm; u.pn = g; u.aux = 0; return true; }
    __device__ __forceinline__ void a_ready(const Unit&) const {}
    __device__ __forceinline__ unsigned row_off(const Unit&, int) const { return 0u; }
};
struct MoeSched {
    const char* A; const char* B; const volatile LAS int* tab; const int* list; int nN, nt, G, c; size_t strideA, strideBe, strideBn; bool gather;
    __device__ __forceinline__ bool next(int i, Unit& u) const { const int NT = tab[8]; int pm, pn; if (!pg8::tile_of(i * G + c, NT, nN, pm, pn)) return false;
        int e = 0;
#pragma unroll
        for (int k = 1; k < 8; ++k) e += (pm >= tab[k]) ? 1 : 0;
        u.A = gather ? A : A + (size_t)pm * strideA; u.B = B + (size_t)e * strideBe + (size_t)pn * strideBn; u.nt = nt; u.pm = pm; u.pn = pn; u.aux = e; return true; }
    __device__ __forceinline__ void a_ready(const Unit&) const {}
    __device__ __forceinline__ unsigned row_off(const Unit& u, int r) const {
        const int e = u.aux, r0 = (u.pm - tab[e]) * 256, cnt = tab[16 + e]; const int rr = (r0 + r < cnt) ? r0 + r : r0;
        return (unsigned)list[e * M + rr] * (unsigned)(D * 2); }
};

struct EpiInProj {
    static constexpr bool PERM = true;
    bf16* O; const float* cosT; const float* sinT;
    __device__ __forceinline__ void operator()(const f32x4 (&acc)[2][2][4][2], const Unit& u, int wr, int wc, int fr, int fq) const {
        const int row0 = u.pm * 256 + wr * 64 + fr, col0 = u.pn * 256 + wc * 32 + 8 * fq;
        const int mode = (u.pn >= 34) ? 2 : ((u.pn >= 12 && u.pn < 24) ? 1 : 0);
#pragma unroll
        for (int ai = 0; ai < 2; ++ai)
#pragma unroll
            for (int m = 0; m < 4; ++m) { const int row = row0 + ai * 128 + m * 16; bf16* rowp = O + (size_t)row * NIN + col0;
                f32x4 c0 = {1.f, 1.f, 1.f, 1.f}, c1 = c0, s0 = {0.f, 0.f, 0.f, 0.f}, s1 = s0;
                if (mode == 1 && wc == 0) { const int pos = row & (SEQ - 1), j0 = 8 * (fq & 1);
                    c0 = *(const f32x4*)(cosT + pos * 16 + j0); c1 = *(const f32x4*)(cosT + pos * 16 + j0 + 4);
                    s0 = *(const f32x4*)(sinT + pos * 16 + j0); s1 = *(const f32x4*)(sinT + pos * 16 + j0 + 4);
                    if (fq < 2) { s0 = -s0; s1 = -s1; } }
#pragma unroll
                for (int bj = 0; bj < 2; ++bj) { f32x4 v0 = acc[ai][bj][m][0], v1 = acc[ai][bj][m][1];
                    if (mode == 1 && wc == 0) { f32x4 o0, o1;
#pragma unroll
                        for (int j = 0; j < 4; ++j) { o0[j] = __shfl_xor(v0[j], 32); o1[j] = __shfl_xor(v1[j], 32); }
                        v0 = v0 * c0 + o0 * s0; v1 = v1 * c1 + o1 * s1; }
                    if (mode == 2) {
#pragma unroll
                        for (int j = 0; j < 4; ++j) { v0[j] = fast_sigmoid(v0[j]); v1[j] = fast_sigmoid(v1[j]); } }
                    u32x4 w; w.x = cvt_pk_bf16(v0[0], v0[1]); w.y = cvt_pk_bf16(v0[2], v0[3]); w.z = cvt_pk_bf16(v1[0], v1[1]); w.w = cvt_pk_bf16(v1[2], v1[3]);
                    *(u32x4*)(rowp + bj * 128) = w; }
                asm volatile("" ::: "memory"); }
    }
};
struct EpiBf16 {
    static constexpr bool PERM = true;
    bf16* O; int ldc, coff; const float* scale;
    __device__ __forceinline__ void operator()(const f32x4 (&acc)[2][2][4][2], const Unit& u, int wr, int wc, int fr, int fq) const {
        const int row0 = u.pm * 256 + wr * 64 + fr, cl = u.pn * 256 + wc * 32 + 8 * fq;
        f32x4 sv[2][2];
#pragma unroll
        for (int bj = 0; bj < 2; ++bj)
#pragma unroll
            for (int n = 0; n < 2; ++n) sv[bj][n] = scale ? *(const f32x4*)(scale + cl + bj * 128 + 4 * n) : (f32x4){1.f, 1.f, 1.f, 1.f};
#pragma unroll
        for (int ai = 0; ai < 2; ++ai)
#pragma unroll
            for (int m = 0; m < 4; ++m) { bf16* rowp = O + (size_t)(row0 + ai * 128 + m * 16) * ldc + coff + cl;
#pragma unroll
                for (int bj = 0; bj < 2; ++bj) { const f32x4 v0 = acc[ai][bj][m][0] * sv[bj][0], v1 = acc[ai][bj][m][1] * sv[bj][1];
                    u32x4 w; w.x = cvt_pk_bf16(v0[0], v0[1]); w.y = cvt_pk_bf16(v0[2], v0[3]); w.z = cvt_pk_bf16(v1[0], v1[1]); w.w = cvt_pk_bf16(v1[2], v1[3]);
                    *(u32x4*)(rowp + bj * 128) = w; }
                asm volatile("" ::: "memory"); }
    }
};
struct EpiSwiGLU {
    static constexpr bool PERM = true;
    bf16* H;
    __device__ __forceinline__ void operator()(const f32x4 (&acc)[2][2][4][2], const Unit& u, int wr, int wc, int fr, int fq) const {
        const int row0 = u.pm * 256 + wr * 64 + fr, col0 = u.pn * 128 + wc * 32 + 8 * fq;
#pragma unroll
        for (int ai = 0; ai < 2; ++ai)
#pragma unroll
            for (int m = 0; m < 4; ++m) { bf16* rowp = H + (size_t)(row0 + ai * 128 + m * 16) * FF + col0;
                f32x4 o[2];
#pragma unroll
                for (int n = 0; n < 2; ++n)
#pragma unroll
                    for (int j = 0; j < 4; ++j) { const float g = acc[ai][0][m][n][j], up = acc[ai][1][m][n][j]; o[n][j] = g * fast_sigmoid(g) * up; }
                u32x4 w; w.x = cvt_pk_bf16(o[0][0], o[0][1]); w.y = cvt_pk_bf16(o[0][2], o[0][3]); w.z = cvt_pk_bf16(o[1][0], o[1][1]); w.w = cvt_pk_bf16(o[1][2], o[1][3]);
                *(u32x4*)rowp = w; asm volatile("" ::: "memory"); }
    }
};
struct EpiBranch {
    static constexpr bool PERM = true;
    const bf16* proj; float* scr; bf16* O;
    __device__ __forceinline__ void operator()(const f32x4 (&acc)[2][2][4][2], const Unit& u, int wr, int wc, int fr, int fq) const {
        const int seg = u.aux, row0 = u.pm * 256 + wr * 64 + fr, cl = u.pn * 256 + wc * 32 + 8 * fq;
        int t_ = threadIdx.x; asm volatile("" : "+v"(t_)); GAS float* sp = (GAS float*)scr + (size_t)t_ * 4;
#pragma unroll
        for (int ai = 0; ai < 2; ++ai)
#pragma unroll
            for (int m = 0; m < 4; ++m) { const int row = row0 + ai * 128 + m * 16; const bf16* gp = proj + (size_t)row * NIN + C_G + seg * D + cl;
#pragma unroll
                for (int bj = 0; bj < 2; ++bj) { const u32x4 gw = *(const u32x4*)(gp + bj * 128); float g[8]; unpack8(gw, g);
                    f32x4 v0 = acc[ai][bj][m][0], v1 = acc[ai][bj][m][1];
                    v0[0] *= g[0]; v0[1] *= g[1]; v0[2] *= g[2]; v0[3] *= g[3]; v1[0] *= g[4]; v1[1] *= g[5]; v1[2] *= g[6]; v1[3] *= g[7];
                    asm volatile("" : "+v"(sp));
                    if (seg > 0) { v0 += *(const GAS f32x4*)sp; v1 += *(const GAS f32x4*)(sp + 512 * 4); }
                    if (seg < 2) { *(GAS f32x4*)sp = v0; *(GAS f32x4*)(sp + 512 * 4) = v1; }
                    else { u32x4 w; w.x = cvt_pk_bf16(v0[0], v0[1]); w.y = cvt_pk_bf16(v0[2], v0[3]); w.z = cvt_pk_bf16(v1[0], v1[1]); w.w = cvt_pk_bf16(v1[2], v1[3]);
                        *(u32x4*)(O + (size_t)row * D + cl + bj * 128) = w; }
                    sp += 2 * 512 * 4;
                    asm volatile("" ::: "memory"); } }
    }
};
struct EpiResid {
    static constexpr bool PERM = false;
    const float* X; float* R;
    __device__ __forceinline__ void operator()(const f32x4 (&acc)[2][2][4][2], const Unit& u, int wr, int wc, int fr, int fq) const {
        const int row0 = u.pm * 256 + wr * 64 + fr, col0 = u.pn * 256 + wc * 32 + 4 * fq;
#pragma unroll
        for (int ai = 0; ai < 2; ++ai)
#pragma unroll
            for (int m = 0; m < 4; ++m) { const size_t off = (size_t)(row0 + ai * 128 + m * 16) * D + col0;
#pragma unroll
                for (int bj = 0; bj < 2; ++bj)
#pragma unroll
                    for (int n = 0; n < 2; ++n) { const f32x4 xv = *(const f32x4*)(X + off + bj * 128 + n * 16); *(f32x4*)(R + off + bj * 128 + n * 16) = xv * ALPHA + acc[ai][bj][m][n]; }
                asm volatile("" ::: "memory"); }
    }
};

struct Ctx { LAS unsigned char* lds; int tid, lane, wave, G, vcu; };

__device__ __forceinline__ void transpose_item(const float* W, int N, bf16* WT, int ldt, int coloff, int mode, LAS float* scr, int kb, int nb, int lane) {
    const int k0 = 64 * kb, n0 = 32 * nb;
#pragma unroll 8
    for (int i = 0; i < 32; ++i) { const int kk = 2 * i + (lane >> 5); scr[kk * 33 + (lane & 31)] = W[(size_t)(k0 + kk) * N + n0 + (lane & 31)]; }
    LDS_WAIT(); asm volatile("" ::: "memory");
    const int c = lane & 7;
#pragma unroll
    for (int j = 0; j < 4; ++j) { const int n = (lane >> 3) + 8 * j; const LAS float* s = scr + (8 * c) * 33 + n; const int nc = n0 + n;
        const int drow = mode == 0 ? nc : ((nc >> 7) * 256 + (nc & 127) + (mode == 2 ? 128 : 0));
        u32x4 o; o.x = cvt_pk_bf16(s[0 * 33], s[1 * 33]); o.y = cvt_pk_bf16(s[2 * 33], s[3 * 33]); o.z = cvt_pk_bf16(s[4 * 33], s[5 * 33]); o.w = cvt_pk_bf16(s[6 * 33], s[7 * 33]);
        *(u32x4*)(WT + (size_t)drow * ldt + coloff + k0 + 8 * c) = o; }
    LDS_WAIT(); asm volatile("" ::: "memory");
}
struct Job { const float* src; bf16* dst; int K, N, ldt, coloff, mode; };
__device__ __forceinline__ Job get_job(const Args& a, int j) {
    Job J; unsigned char* ws = a.ws;
    if (j < 12) { const int l = j / 6, k = j - 6 * l, ib = l ? 16 : 1; unsigned char* wl = ws + WS_WL + (size_t)l * WL_STRIDE;
        if (k == 0)      { J.src = a.in[ib + 0]; J.dst = (bf16*)(wl + WL_WIN); J.K = D;    J.N = NIN; J.ldt = D;    J.coloff = 0;    J.mode = 0; }
        else if (k == 1) { J.src = a.in[ib + 2]; J.dst = (bf16*)(wl + WL_WBR); J.K = 1024; J.N = D;   J.ldt = KBR;  J.coloff = 0;    J.mode = 0; }
        else if (k == 2) { J.src = a.in[ib + 3]; J.dst = (bf16*)(wl + WL_WBR); J.K = 512;  J.N = D;   J.ldt = KBR;  J.coloff = 1024; J.mode = 0; }
        else if (k == 3) { J.src = a.in[ib + 6]; J.dst = (bf16*)(wl + WL_WBR); J.K = 1024; J.N = D;   J.ldt = KBR;  J.coloff = 1536; J.mode = 0; }
        else if (k == 4) { J.src = a.in[ib + 4]; J.dst = (bf16*)(wl + WL_PM);  J.K = 1024; J.N = 256; J.ldt = 1024; J.coloff = 0;    J.mode = 0; }
        else             { J.src = a.in[ib + 7]; J.dst = (bf16*)(wl + WL_WO);  J.K = D;    J.N = D;   J.ldt = D;    J.coloff = 0;    J.mode = 0; }
        return J; }
    j -= 12;
    const int e = j < 3 ? 0 : (j - 3) / 3, k = j < 3 ? j : (j - 3) % 3;
    unsigned char* wf = j < 3 ? ws + WS_FFN0 : ws + WS_MOE + (size_t)e * FFN_STRIDE;
    const float* g = j < 3 ? a.in[11] : a.in[27] + (size_t)e * D * FF; const float* up = j < 3 ? a.in[12] : a.in[28] + (size_t)e * D * FF; const float* dn = j < 3 ? a.in[13] : a.in[29] + (size_t)e * D * FF;
    if (k == 0)      { J.src = g;  J.dst = (bf16*)(wf + FFN_WGU); J.K = D;  J.N = FF; J.ldt = D;  J.coloff = 0; J.mode = 1; }
    else if (k == 1) { J.src = up; J.dst = (bf16*)(wf + FFN_WGU); J.K = D;  J.N = FF; J.ldt = D;  J.coloff = 0; J.mode = 2; }
    else             { J.src = dn; J.dst = (bf16*)(wf + FFN_WD);  J.K = FF; J.N = D;  J.ldt = FF; J.coloff = 0; J.mode = 0; }
    return J;
}
__device__ __forceinline__ void sincos_f64(double r, double& s, double& c) {
    const double hp = 1.57079632679489661923; const double kq = __builtin_rint(r / hp); const double y = r - kq * hp; const int q = ((int)kq) & 3; const double y2 = y * y;
    double sp = -7.6471637318198164759e-13; sp = sp * y2 + 1.6059043836821614599e-10; sp = sp * y2 - 2.5052108385441718775e-8; sp = sp * y2 + 2.7557319223985890653e-6; sp = sp * y2 - 1.9841269841269841270e-4; sp = sp * y2 + 8.3333333333333333333e-3; sp = sp * y2 - 1.6666666666666666667e-1; const double sy = y + y * y2 * sp;
    double cp = 4.7794773323873852974e-14; cp = cp * y2 - 1.1470745597729724714e-11; cp = cp * y2 + 2.0876756987868098979e-9; cp = cp * y2 - 2.7557319223985890653e-7; cp = cp * y2 + 2.4801587301587301587e-5; cp = cp * y2 - 1.3888888888888888889e-3; cp = cp * y2 + 4.1666666666666666667e-2; cp = cp * y2 - 0.5; const double cy = 1.0 + y2 * cp;
    s = (q == 0) ? sy : (q == 1) ? cy : (q == 2) ? -sy : -cy; c = (q == 0) ? cy : (q == 1) ? -sy : (q == 2) ? -cy : sy;
}
__device__ __forceinline__ void p_prologue(const Args& a, const Ctx& F) {
    LAS float* scr = (LAS float*)(F.lds + F.wave * 16384);
    const int gw = F.vcu * 8 + F.wave, NGW = F.G * 8;
    for (int j = 0; j < 39; ++j) { const Job J = get_job(a, j); const int nblk = J.N / 32, items = (J.K / 64) * nblk;
        for (int it = gw; it < items; it += NGW) transpose_item(J.src, J.N, J.dst, J.ldt, J.coloff, J.mode, scr, it / nblk, it % nblk, F.lane); }
    { const float* x = a.in[0]; bf16* xb = (bf16*)(a.ws + WS_XB); const size_t n8 = (size_t)M * D / 8;
      for (size_t i = (size_t)blockIdx.x * 512 + F.tid; i < n8; i += (size_t)F.G * 512) { const f32x4 v0 = *(const f32x4*)(x + i * 8), v1 = *(const f32x4*)(x + i * 8 + 4);
          u32x4 w; w.x = cvt_pk_bf16(v0[0], v0[1]); w.y = cvt_pk_bf16(v0[2], v0[3]); w.z = cvt_pk_bf16(v1[0], v1[1]); w.w = cvt_pk_bf16(v1[2], v1[3]); *(u32x4*)(xb + i * 8) = w; } }
    { float* cosT = (float*)(a.ws + WS_ROT); float* sinT = cosT + SEQ * 16;
      for (int i = blockIdx.x * 512 + F.tid; i < SEQ * 16; i += F.G * 512) { const int pos = i >> 4, j = i & 15; const float ang = (float)pos * a.inv_freq[j];
          const double tp = 6.28318530717958647692; const double ad = (double)ang; const double r = ad - tp * __builtin_rint(ad / tp); double s, c; sincos_f64(r, s, c); cosT[i] = (float)c; sinT[i] = (float)s; } }
}

__device__ __forceinline__ unsigned vtile_off(unsigned row, unsigned ch) { return 256u * row + 16u * (ch ^ (((row & 3u) << 2) | ((row >> 2) & 3u))); }
__device__ __forceinline__ s16x4 tr16(LAS unsigned char* p) { typedef short v4i16_t __attribute__((ext_vector_type(4))); return __builtin_bit_cast(s16x4, __builtin_amdgcn_ds_read_tr16_b64_v4i16((LAS v4i16_t*)p)); }
__device__ __forceinline__ void attn_unit(const Ctx& F, const bf16* proj, bf16* att, float* lse, int unit) {
    const int g = unit >> 9, rem = unit & 511, b = rem >> 7, hg = (rem >> 5) & 3, cb = rem & 31;
    const int dsh = 2 * g, d = 1 << dsh, nblk = 32 >> dsh, c = cb / nblk, blk = cb % nblk, L = SEQ >> dsh, L0 = blk * 128, head = g * 4 + hg;
    const bf16* pb = proj + (size_t)b * SEQ * NIN;
    LAS unsigned char* vt = F.lds;
#pragma unroll
    for (int it = 0; it < 9; ++it) { const int ch = F.tid + 512 * it; if (ch < 272 * 16) { const int row = ch >> 4, c16 = ch & 15, sub = L0 - 128 + row; u32x4 v = {0u, 0u, 0u, 0u};
        if (sub >= 0 && sub < L) v = *(const u32x4*)(pb + (size_t)(sub * d + c) * NIN + C_V + head * 128 + c16 * 8);
        *(LAS u32x4*)(vt + vtile_off(row, c16)) = v; } }
    __syncthreads();
    const int lane = F.lane, w = F.wave, q = lane & 15, g4 = lane >> 4, l0 = L0 + 16 * w, kwin0 = l0 - 128;
    const size_t qrow = (size_t)((l0 + q) * d + c);
    bf16x8 qf[4];
#pragma unroll
    for (int s = 0; s < 4; ++s) qf[s] = *(const bf16x8*)(pb + qrow * NIN + C_Q + head * 128 + 32 * s + 8 * g4);
    f32x4 S[5][2];
#pragma unroll
    for (int ks = 0; ks < 5; ++ks)
#pragma unroll
        for (int t = 0; t < 2; ++t) { int ksub = kwin0 + 32 * ks + 8 * (q >> 2) + 4 * t + (q & 3); ksub = ksub < 0 ? 0 : (ksub > L - 1 ? L - 1 : ksub);
            const bf16* kp = pb + (size_t)(ksub * d + c) * NIN + C_K + head * 128 + 8 * g4; f32x4 sa = {0.f, 0.f, 0.f, 0.f};
#pragma unroll
            for (int s = 0; s < 4; ++s) { const bf16x8 kf = *(const bf16x8*)(kp + 32 * s); sa = __builtin_amdgcn_mfma_f32_16x16x32_bf16(kf, qf[s], sa, 0, 0, 0); }
            S[ks][t] = sa; }
    const float sc = 0.08838834764831845f * 1.4426950408889634f; float mx = -1e30f;
#pragma unroll
    for (int ks = 0; ks < 5; ++ks)
#pragma unroll
        for (int t = 0; t < 2; ++t)
#pragma unroll
            for (int r = 0; r < 4; ++r) { const int jj = 32 * ks + 8 * g4 + 4 * t + r; const bool ok = (jj >= q) && (jj <= q + 128) && (kwin0 + jj >= 0);
                const float v = ok ? S[ks][t][r] * sc : -1e30f; S[ks][t][r] = v; mx = fmaxf(mx, v); }
    mx = fmaxf(mx, __shfl_xor(mx, 16)); mx = fmaxf(mx, __shfl_xor(mx, 32));
    float sum = 0.f; bf16x8 pf[5];
#pragma unroll
    for (int ks = 0; ks < 5; ++ks) { float p[8];
#pragma unroll
        for (int t = 0; t < 2; ++t)
#pragma unroll
            for (int r = 0; r < 4; ++r) { const float e = __builtin_amdgcn_exp2f(S[ks][t][r] - mx); p[4 * t + r] = e; sum += e; }
        const u32x4 pw = pack8(p); pf[ks] = __builtin_bit_cast(bf16x8, pw); }
    sum += __shfl_xor(sum, 16); sum += __shfl_xor(sum, 32);
    const float inv = 1.0f / sum;
    LAS unsigned char* vb = vt + 0;
    const unsigned trq = (lane & 15) >> 2, trp = lane & 3;
    bf16* op = att + ((size_t)g * M + (size_t)b * SEQ + qrow) * 512 + hg * 128 + 4 * g4;
#pragma unroll
    for (int cc = 0; cc < 8; ++cc) { f32x4 o = {0.f, 0.f, 0.f, 0.f};
#pragma unroll
        for (int ks = 0; ks < 5; ++ks) { const unsigned rb = 16u * w + 32u * ks + 8u * g4 + trq;
            const s16x4 lo = tr16(vb + vtile_off(rb, 2u * cc + (trp >> 1)) + 8u * (trp & 1)), hi = tr16(vb + vtile_off(rb + 4u, 2u * cc + (trp >> 1)) + 8u * (trp & 1));
            const bf16x8 vf = {lo[0], lo[1], lo[2], lo[3], hi[0], hi[1], hi[2], hi[3]};
            o = __builtin_amdgcn_mfma_f32_16x16x32_bf16(vf, pf[ks], o, 0, 0, 0); }
        u32x2 ow; ow.x = cvt_pk_bf16(o[0] * inv, o[1] * inv); ow.y = cvt_pk_bf16(o[2] * inv, o[3] * inv); *(u32x2*)(op + 16 * cc) = ow; }
    if (g4 == 0) lse[((size_t)g * M + (size_t)b * SEQ + qrow) * 4 + hg] = mx + __builtin_amdgcn_logf(sum);
    __syncthreads();
}
__device__ __forceinline__ void p_mixA(const Args& a, const Ctx& F, int layer) {
    const bf16* proj = (const bf16*)(a.ws + WS_BIG + BIG_PROJ); bf16* att = (bf16*)(a.ws + WS_ATT); float* lse = (float*)(a.ws + WS_LSE);
    for (int u = blockIdx.x; u < 1536; u += F.G) attn_unit(F, proj, att, lse, u);
    bf16* pooled = (bf16*)(a.ws + WS_Y + Y_POOLED);
    for (int i = blockIdx.x * 512 + F.tid; i < M * 128; i += F.G * 512) { const int row = i >> 7, c8 = i & 127, t = row & (SEQ - 1), gi = c8 >> 5, w = 2 << gi; const int n = (t + 1 < w) ? t + 1 : w;
        const bf16* p = proj + (size_t)row * NIN + C_PU + c8 * 8; float s[8] = {0.f, 0.f, 0.f, 0.f, 0.f, 0.f, 0.f, 0.f}, cur[8];
        for (int k = 0; k < n; ++k) { float f[8]; unpack8(*(const u32x4*)(p - (size_t)k * NIN), f);
#pragma unroll
            for (int j = 0; j < 8; ++j) { s[j] += f[j]; if (k == 0) cur[j] = f[j]; } }
        const float rn = 1.0f / (float)n; float o[8];
#pragma unroll
        for (int j = 0; j < 8; ++j) o[j] = s[j] * rn - cur[j];
        *(u32x4*)(pooled + (size_t)row * 1024 + c8 * 8) = pack8(o); }
    const float* cw = a.in[(layer ? 16 : 1) + 1]; bf16* abr = (bf16*)(a.ws + WS_BIG + BIG_ABR);
    for (int i = blockIdx.x * 512 + F.tid; i < M * 128; i += F.G * 512) { const int row = i >> 7, c8 = i & 127, t = row & (SEQ - 1);
        const bf16* p = proj + (size_t)row * NIN + c8 * 8; float accv[8] = {0.f, 0.f, 0.f, 0.f, 0.f, 0.f, 0.f, 0.f};
#pragma unroll
        for (int k = 0; k < 3; ++k) { if (t - k >= 0) { float cc[8], ch[8]; unpack8(*(const u32x4*)(p + C_CC - (size_t)k * NIN), cc); unpack8(*(const u32x4*)(p + C_CH - (size_t)k * NIN), ch);
            const f32x4 w0 = *(const f32x4*)(cw + (2 - k) * 1024 + c8 * 8), w1 = *(const f32x4*)(cw + (2 - k) * 1024 + c8 * 8 + 4);
#pragma unroll
            for (int j = 0; j < 4; ++j) { accv[j] += cc[j] * ch[j] * w0[j]; accv[4 + j] += cc[4 + j] * ch[4 + j] * w1[j]; } } }
        float cbv[8]; unpack8(*(const u32x4*)(p + C_CB), cbv);
#pragma unroll
        for (int j = 0; j < 8; ++j) accv[j] *= cbv[j];
        *(u32x4*)(abr + (size_t)row * KBR + c8 * 8) = pack8(accv); }
}
__device__ __forceinline__ void p_combine(const Args& a, const Ctx& F) {
    const bf16* att = (const bf16*)(a.ws + WS_ATT); const float* lse = (const float*)(a.ws + WS_LSE); bf16* abr = (bf16*)(a.ws + WS_BIG + BIG_ABR);
    for (int i = blockIdx.x * 512 + F.tid; i < M * 64; i += F.G * 512) { const int row = i >> 6, c8 = i & 63, hg = c8 >> 4;
        const float l0 = lse[((size_t)0 * M + row) * 4 + hg], l1 = lse[((size_t)1 * M + row) * 4 + hg], l2 = lse[((size_t)2 * M + row) * 4 + hg];
        const float mx = fmaxf(l0, fmaxf(l1, l2)); float w0 = __builtin_amdgcn_exp2f(l0 - mx), w1 = __builtin_amdgcn_exp2f(l1 - mx), w2 = __builtin_amdgcn_exp2f(l2 - mx); const float inv = 1.0f / (w0 + w1 + w2); w0 *= inv; w1 *= inv; w2 *= inv;
        float f0[8], f1[8], f2[8], o[8]; unpack8(*(const u32x4*)(att + ((size_t)0 * M + row) * 512 + c8 * 8), f0); unpack8(*(const u32x4*)(att + ((size_t)1 * M + row) * 512 + c8 * 8), f1); unpack8(*(const u32x4*)(att + ((size_t)2 * M + row) * 512 + c8 * 8), f2);
#pragma unroll
        for (int j = 0; j < 8; ++j) o[j] = w0 * f0[j] + w1 * f1[j] + w2 * f2[j];
        *(u32x4*)(abr + (size_t)row * KBR + 1024 + c8 * 8) = pack8(o); }
}

template <int MODE>
__device__ __forceinline__ void p_layernorm(const Args& a, const Ctx& F, const float* gam, const float* bet, const float* wr) {
    float* R = a.out; bf16* XB = (bf16*)(a.ws + WS_XB); gu32* ctl = (gu32*)(a.ws + WS_CTL);
    int* list = (int*)(a.ws + WS_LIST); unsigned* info = (unsigned*)(a.ws + WS_INFO); const bf16* Y = (const bf16*)(a.ws + WS_Y);
    volatile LAS int* tab = (volatile LAS int*)(F.lds + TAB_OFF);
    LAS int* lcnt = (LAS int*)(F.lds + 0); LAS int* lbase = (LAS int*)(F.lds + 64); LAS unsigned* sel = (LAS unsigned*)(F.lds + 128);
    const int lane = F.lane;
    if (MODE == 2) {
        if (F.tid == 0) { int s = 0; for (int e = 0; e < 8; ++e) { const int cnt = (int)__hip_atomic_load(ctl + CW_CNT + 64 * e, RLX_AGENT); tab[e] = s; tab[16 + e] = cnt; s += (cnt + 255) >> 8; } tab[8] = s; }
        __syncthreads(); }
    f32x4 gv[8], bv[8];
#pragma unroll
    for (int j = 0; j < 8; ++j) { gv[j] = *(const f32x4*)(gam + 4 * lane + 256 * j); bv[j] = *(const f32x4*)(bet + 4 * lane + 256 * j); }
    for (int blk = blockIdx.x; blk < M / 64; blk += F.G) {
        if (MODE == 1) { if (F.tid < 8) lcnt[F.tid] = 0; __syncthreads(); }
        for (int rr = 0; rr < 8; ++rr) { const int rl = F.wave * 8 + rr, row = blk * 64 + rl;
            float* rp = R + (size_t)row * D + 4 * lane; f32x4 v[8];
#pragma unroll
            for (int j = 0; j < 8; ++j) v[j] = *(const f32x4*)(rp + 256 * j);
            if (MODE == 2) { const u32x4 i0 = *(const u32x4*)(info + (size_t)row * 8); const u32x2 i1 = *(const u32x2*)(info + (size_t)row * 8 + 4);
                const int s0 = tab[i0.x] * 256 + (int)i0.y, s1 = tab[i0.z] * 256 + (int)i0.w; const float g0 = __uint_as_float(i1.x), g1 = __uint_as_float(i1.y);
                const bf16* y0 = Y + (size_t)s0 * D + 4 * lane; const bf16* y1 = Y + (size_t)s1 * D + 4 * lane;
#pragma unroll
                for (int j = 0; j < 8; ++j) { const u32x2 a0 = *(const u32x2*)(y0 + 256 * j), a1 = *(const u32x2*)(y1 + 256 * j);
                    v[j][0] = v[j][0] * ALPHA + g0 * bflo(a0.x) + g1 * bflo(a1.x); v[j][1] = v[j][1] * ALPHA + g0 * bfhi(a0.x) + g1 * bfhi(a1.x);
                    v[j][2] = v[j][2] * ALPHA + g0 * bflo(a0.y) + g1 * bflo(a1.y); v[j][3] = v[j][3] * ALPHA + g0 * bfhi(a0.y) + g1 * bfhi(a1.y); } }
            float s = 0.f;
#pragma unroll
            for (int j = 0; j < 8; ++j) s += (v[j][0] + v[j][1]) + (v[j][2] + v[j][3]);
            const float mean = wave_sum(s) * (1.f / D); float s2 = 0.f;
#pragma unroll
            for (int j = 0; j < 8; ++j) { v[j] = v[j] - mean; s2 += (v[j][0] * v[j][0] + v[j][1] * v[j][1]) + (v[j][2] * v[j][2] + v[j][3] * v[j][3]); }
            const float rstd = 1.f / sqrtf(wave_sum(s2) * (1.f / D) + LN_EPS);
            bf16* xp = XB + (size_t)row * D + 4 * lane;
#pragma unroll
            for (int j = 0; j < 8; ++j) { v[j] = v[j] * rstd * gv[j] + bv[j]; *(f32x4*)(rp + 256 * j) = v[j];
                u32x2 w; w.x = cvt_pk_bf16(v[j][0], v[j][1]); w.y = cvt_pk_bf16(v[j][2], v[j][3]); *(u32x2*)(xp + 256 * j) = w; }
            if (MODE == 1) {
                float lg[8] = {0.f, 0.f, 0.f, 0.f, 0.f, 0.f, 0.f, 0.f};
#pragma unroll
                for (int j = 0; j < 8; ++j)
#pragma unroll
                    for (int k = 0; k < 4; ++k) { const float* wp = wr + (size_t)(4 * lane + 256 * j + k) * 8; const f32x4 wa = *(const f32x4*)wp, wb = *(const f32x4*)(wp + 4); const float xv = v[j][k];
                        lg[0] += xv * wa[0]; lg[1] += xv * wa[1]; lg[2] += xv * wa[2]; lg[3] += xv * wa[3]; lg[4] += xv * wb[0]; lg[5] += xv * wb[1]; lg[6] += xv * wb[2]; lg[7] += xv * wb[3]; }
#pragma unroll
                for (int e = 0; e < 8; ++e) lg[e] = wave_sum(lg[e]);
                int e0 = 0; float v0 = lg[0];
#pragma unroll
                for (int e = 1; e < 8; ++e) if (lg[e] > v0) { v0 = lg[e]; e0 = e; }
                int e1 = -1; float v1 = -3.0e38f;
#pragma unroll
                for (int e = 0; e < 8; ++e) if (e != e0 && lg[e] > v1) { v1 = lg[e]; e1 = e; }
                const float ex = __expf(v1 - v0), g0 = 1.0f / (1.0f + ex), g1 = ex * g0;
                if (lane == 0) { const int r0 = __hip_atomic_fetch_add(lcnt + e0, 1, __ATOMIC_RELAXED, __HIP_MEMORY_SCOPE_WORKGROUP), r1 = __hip_atomic_fetch_add(lcnt + e1, 1, __ATOMIC_RELAXED, __HIP_MEMORY_SCOPE_WORKGROUP);
                    sel[rl * 6 + 0] = (unsigned)e0; sel[rl * 6 + 1] = (unsigned)r0; sel[rl * 6 + 2] = (unsigned)e1; sel[rl * 6 + 3] = (unsigned)r1; sel[rl * 6 + 4] = __float_as_uint(g0); sel[rl * 6 + 5] = __float_as_uint(g1); } }
        }
        if (MODE == 1) { __syncthreads();
            if (F.tid < 8) lbase[F.tid] = (int)__hip_atomic_fetch_add(ctl + CW_CNT + 64 * F.tid, (unsigned)lcnt[F.tid], RLX_AGENT);
            __syncthreads();
            if (F.tid < 64) { const int row = blk * 64 + F.tid; const unsigned e0 = sel[F.tid * 6], r0 = sel[F.tid * 6 + 1] + (unsigned)lbase[e0], e1 = sel[F.tid * 6 + 2], r1 = sel[F.tid * 6 + 3] + (unsigned)lbase[e1];
                u32x4 i0 = {e0, r0, e1, r1}; u32x4 i1 = {sel[F.tid * 6 + 4], sel[F.tid * 6 + 5], 0u, 0u}; *(u32x4*)(info + (size_t)row * 8) = i0; *(u32x4*)(info + (size_t)row * 8 + 4) = i1;
                list[e0 * M + r0] = row; list[e1 * M + r1] = row; }
            __syncthreads(); }
    }
}

constexpr int NPHASE = 19;
__global__ void __launch_bounds__(512, 2) fwd(Args args) {
    extern __shared__ __attribute__((aligned(16))) unsigned char lds_raw[];
    Ctx F; F.lds = (LAS unsigned char*)lds_raw; F.tid = threadIdx.x; F.lane = F.tid & 63; F.wave = __builtin_amdgcn_readfirstlane(F.tid >> 6);
    F.G = gridDim.x; { const int bx = blockIdx.x; F.vcu = (F.G % 8 == 0) ? (bx % 8) * (F.G / 8) + bx / 8 : bx; }
    unsigned char* ws = args.ws; gu32* ctl = (gu32*)(ws + WS_CTL);
    for (int u = F.tid; u < (LDS_BYTES - LDSCTL_OFF) / 4; u += 512) ((LAS unsigned*)(F.lds + LDSCTL_OFF))[u] = 0u;
    __syncthreads();
    volatile LAS unsigned* MISC = (volatile LAS unsigned*)(F.lds + MISC_OFF);
    XcdBarrier bar; bar.bar = (unsigned*)(ctl + CW_BAR); bar.x = 0; bar.st = nullptr;
    if (MK_N_LAUNCHES == 1) bar = xcd_barrier_post((unsigned*)(ctl + CW_BAR), MISC + 8);
    const int lo = args.ph_lo, hi = args.ph_hi;
#define RUN(k) (lo <= (k) && (k) < hi)
#define LAUNDER() do { int t_ = threadIdx.x; asm volatile("" : "+v"(t_)); F.tid = t_; F.lane = t_ & 63; F.wave = __builtin_amdgcn_readfirstlane(t_ >> 6); } while (0)
#define SEAM(k) do { if (MK_N_LAUNCHES == 1 && RUN(k) && RUN((k) + 1)) xcd_barrier(bar); } while (0)
    const int G = F.G, cid = (int)blockIdx.x;
    const bf16* XB = (const bf16*)(ws + WS_XB);
    bf16* proj = (bf16*)(ws + WS_BIG + BIG_PROJ); bf16* abr = (bf16*)(ws + WS_BIG + BIG_ABR); bf16* mrg = (bf16*)(ws + WS_BIG + BIG_MRG); bf16* hbuf = (bf16*)(ws + WS_BIG);
    const float* cosT = (const float*)(ws + WS_ROT); const float* sinT = cosT + SEQ * 16;
    volatile LAS int* tab = (volatile LAS int*)(F.lds + TAB_OFF);

    if (PH_ON(9) && RUN(0)) { LAUNDER(); p_prologue(args, F); } SEAM(0);

    for (int layer = 0; layer < 2; ++layer) {
        const int pb = 1 + 9 * layer, ib = layer ? 16 : 1;
        unsigned char* wl = ws + WS_WL + (size_t)layer * WL_STRIDE;
        if (PH_ON(0) && RUN(pb + 0)) { DenseSched S{(const char*)XB, (const char*)(wl + WL_WIN), M / 256, NIN / 256, D / 64, G, cid, (size_t)256 * D * 2, (size_t)256 * D * 2};
            EpiInProj E{proj, cosT, sinT};
            pg8::gemm_phase<EpiInProj, DenseSched, false, true, GEMM_SP2>(F.lds, D, D, S, E); }
        SEAM(pb + 0);
        if (PH_ON(1) && RUN(pb + 1)) { LAUNDER(); p_mixA(args, F, layer); }
        SEAM(pb + 1);
        if (PH_ON(2) && RUN(pb + 2)) { LAUNDER(); p_combine(args, F);
            PoolMixSched S{(const char*)(ws + WS_Y + Y_POOLED), (const char*)(wl + WL_PM), G, cid};
            EpiBf16 E{abr, KBR, 1536, args.in[ib + 5]};
            pg8::gemm_phase<EpiBf16, PoolMixSched, false, false, GEMM_SP2>(F.lds, 1024, 1024, S, E); }
        SEAM(pb + 2);
        if (PH_ON(3) && RUN(pb + 3)) { BranchSched S{(const char*)abr, (const char*)(wl + WL_WBR), G, cid};
            EpiBranch E{proj, (float*)(ws + WS_Y + Y_SCR) + (size_t)cid * 65536, mrg};
            pg8::gemm_phase<EpiBranch, BranchSched, false, true, GEMM_SP2>(F.lds, KBR, KBR, S, E); }
        SEAM(pb + 3);
        if (PH_ON(4) && RUN(pb + 4)) { DenseSched S{(const char*)mrg, (const char*)(wl + WL_WO), M / 256, D / 256, D / 64, G, cid, (size_t)256 * D * 2, (size_t)256 * D * 2};
            EpiResid E{layer ? (const float*)args.out : args.in[0], args.out};
            pg8::gemm_phase<EpiResid, DenseSched, false, true, GEMM_SP2>(F.lds, D, D, S, E); }
        SEAM(pb + 4);
        if (PH_ON(5) && RUN(pb + 5)) { LAUNDER(); if (layer == 0) p_layernorm<0>(args, F, args.in[ib + 8], args.in[ib + 9], nullptr); else p_layernorm<1>(args, F, args.in[ib + 8], args.in[ib + 9], args.in[26]); }
        SEAM(pb + 5);
        if (layer == 0) {
          if (PH_ON(10)) {
            if (PH_ON(6) && RUN(pb + 6)) { DenseSched S{(const char*)XB, (const char*)(ws + WS_FFN0 + FFN_WGU), M / 256, 2 * FF / 256, D / 64, G, cid, (size_t)256 * D * 2, (size_t)256 * D * 2};
                EpiSwiGLU E{hbuf};
                pg8::gemm_phase<EpiSwiGLU, DenseSched, false, true, GEMM_SP2>(F.lds, D, D, S, E); }
            SEAM(pb + 6);
            if (PH_ON(7) && RUN(pb + 7)) { DenseSched S{(const char*)hbuf, (const char*)(ws + WS_FFN0 + FFN_WD), M / 256, D / 256, FF / 64, G, cid, (size_t)256 * FF * 2, (size_t)256 * FF * 2};
                EpiResid E{args.out, args.out};
                pg8::gemm_phase<EpiResid, DenseSched, false, true, GEMM_SP2>(F.lds, FF, FF, S, E); }
            SEAM(pb + 7);
            if (PH_ON(8) && RUN(pb + 8)) { LAUNDER(); p_layernorm<0>(args, F, args.in[ib + 13], args.in[ib + 14], nullptr); }
            SEAM(pb + 8);
          }
        } else if (PH_ON(11)) {
            if (RUN(pb + 6) || RUN(pb + 7)) {
                if (F.tid == 0) { int s = 0; for (int e = 0; e < 8; ++e) { const int cnt = (int)__hip_atomic_load(ctl + CW_CNT + 64 * e, RLX_AGENT); tab[e] = s; tab[16 + e] = cnt; s += (cnt + 255) >> 8; } tab[8] = s; }
                __syncthreads(); }
            if (PH_ON(6) && RUN(pb + 6)) { MoeSched S{(const char*)XB, (const char*)(ws + WS_MOE + FFN_WGU), tab, (const int*)(ws + WS_LIST), 2 * FF / 256, D / 64, G, cid, 0, FFN_STRIDE, (size_t)256 * D * 2, true};
                EpiSwiGLU E{hbuf};
                pg8::gemm_phase<EpiSwiGLU, MoeSched, true, true, GEMM_SP2>(F.lds, D, D, S, E); }
            SEAM(pb + 6);
            if (PH_ON(7) && RUN(pb + 7)) { MoeSched S{(const char*)hbuf, (const char*)(ws + WS_MOE + FFN_WD), tab, (const int*)(ws + WS_LIST), D / 256, FF / 64, G, cid, (size_t)256 * FF * 2, FFN_STRIDE, (size_t)256 * FF * 2, false};
                EpiBf16 E{(bf16*)(ws + WS_Y), D, 0, nullptr};
                pg8::gemm_phase<EpiBf16, MoeSched, false, true, GEMM_SP2>(F.lds, FF, FF, S, E); }
            SEAM(pb + 7);
            if (PH_ON(8) && RUN(pb + 8)) { LAUNDER(); p_layernorm<2>(args, F, args.in[ib + 14], args.in[ib + 15], nullptr); }
        }
    }
#undef RUN
#undef LAUNDER
#undef SEAM
}

extern "C" void kernel_launch(void* const* d_in, const int* in_sizes, int n_in, void* d_out, int out_size, void* d_ws, size_t ws_size, hipStream_t stream) {
    static int grid = 0;
    if (grid == 0) {
        if (n_in != 32 || in_sizes[0] != M * D || out_size != M * D || ws_size < WS_END) {
            fprintf(stderr, "kernel_launch: built for 32 inputs, x/out of %d floats, >= %zu bytes of workspace; got n_in %d, in0 %d, out %d, ws %zu; nothing launched\n", M * D, (size_t)WS_END, n_in, n_in > 0 ? in_sizes[0] : -1, out_size, ws_size); grid = -1; return; }
        int dev = 0, cus = 0, per_cu = 0;
        if (hipGetDevice(&dev) != hipSuccess || hipDeviceGetAttribute(&cus, hipDeviceAttributeMultiprocessorCount, dev) != hipSuccess) { fprintf(stderr, "kernel_launch: device query failed\n"); grid = -1; return; }
        if (hipFuncSetAttribute((const void*)fwd, hipFuncAttributeMaxDynamicSharedMemorySize, LDS_BYTES) != hipSuccess) { fprintf(stderr, "kernel_launch: hipFuncSetAttribute failed\n"); grid = -1; return; }
        if (hipOccupancyMaxActiveBlocksPerMultiprocessor(&per_cu, (const void*)fwd, 512, LDS_BYTES) != hipSuccess || per_cu < 1) fprintf(stderr, "kernel_launch: occupancy query reports %d\n", per_cu);
        (void)hipGetLastError();
        grid = cus;
    }
    if (grid < 0) return;
    if (hipMemsetAsync((char*)d_ws + WS_CTL, 0, CTL_ZERO_BYTES, stream) != hipSuccess) { fprintf(stderr, "kernel_launch: memset failed\n"); return; }
    Args a{};
    for (int i = 0; i < 32; ++i) a.in[i] = (const float*)d_in[i];
    a.out = (float*)d_out; a.ws = (unsigned char*)d_ws;
    for (int j = 0; j < 16; ++j) a.inv_freq[j] = powf(500000.0f, -(float)(2 * j) / 32.0f);
#if MK_N_LAUNCHES == 1
    a.ph_lo = 0; a.ph_hi = NPHASE;
    hipLaunchKernelGGL(fwd, dim3(grid), dim3(512), LDS_BYTES, stream, a);
#else
    for (int p = 0; p < NPHASE; ++p) { a.ph_lo = p; a.ph_hi = p + 1; hipLaunchKernelGGL(fwd, dim3(grid), dim3(512), LDS_BYTES, stream, a); }
#endif
    const hipError_t le = hipPeekAtLastError();
    if (le != hipSuccess) fprintf(stderr, "kernel_launch: launch failed: %s\n", hipGetErrorName(le));
}
```

```cpp
#include <hip/hip_runtime.h>
#include <cstdio>
#include <cstdint>
#include <cmath>

#ifndef MK_N_LAUNCHES
#define MK_N_LAUNCHES 1
#endif

#ifndef DIAG
#define DIAG 0
#endif
#ifndef DIAG_A
#define DIAG_A 0
#define DIAG_SA 20.0f
#define DIAG_B 1
#endif
#ifndef PROBE_REP
#define PROBE_REP (-1)
#endif
#ifndef MOE_FP8
#define MOE_FP8 1
#endif
#ifndef GATES_FP8
#define GATES_FP8 1
#endif
#ifndef BR_ALIGN
#define BR_ALIGN GEMM_ALIGN
#endif
#ifndef WO_ALIGN
#define WO_ALIGN GEMM_ALIGN
#endif
#ifndef IP_BAL
#define IP_BAL 1
#endif
#ifndef G8_FIRST
#define G8_FIRST 0
#endif
#ifndef INPROJ_V8
#define INPROJ_V8 2
#endif
#ifndef DENSE_UP8_TILES
#define DENSE_UP8_TILES 24
#endif
#ifndef MOE_SPLIT
#define MOE_SPLIT 1
#endif
#ifndef F8_K128
#define F8_K128 1
#endif
#ifndef G8_ALIGN
#define G8_ALIGN true
#endif
#ifndef MOE8_ALIGN
#define MOE8_ALIGN true
#endif
#ifndef G8_SP2
#define G8_SP2 true
#endif
#ifndef GATES_TEST
#define GATES_TEST 0
#endif
#ifndef GATES_L0
#define GATES_L0 1
#endif
#ifndef GATES_FP8_COMPUTE
#define GATES_FP8_COMPUTE GATES_FP8
#endif
#ifndef DENSE_FP8
#define DENSE_FP8 0
#endif
#ifndef DENSE_DOWN_FP8
#define DENSE_DOWN_FP8 1
#endif
#ifndef CONV_FUSE
#define CONV_FUSE 1
#endif
#ifndef PH_MASK
#define PH_MASK 0xFFFFF
#endif
#ifndef GEMM_SP2
#define GEMM_SP2 true
#endif
#ifndef GEMM_ALIGN
#define GEMM_ALIGN true
#endif
#ifndef GEMM_WGM
#define GEMM_WGM 4
#endif
#define PH_ON(k) (((PH_MASK) >> (k)) & 1)
#define GAS __attribute__((address_space(1)))
#define LAS __attribute__((address_space(3)))
typedef unsigned short bf16;
typedef short bf16x8 __attribute__((ext_vector_type(8)));
typedef short s16x4 __attribute__((ext_vector_type(4)));
typedef float f32x4 __attribute__((ext_vector_type(4)));
typedef float f32x2 __attribute__((ext_vector_type(2)));
typedef unsigned u32x4 __attribute__((ext_vector_type(4)));
typedef unsigned u32x2 __attribute__((ext_vector_type(2)));
typedef GAS unsigned gu32;
typedef int i32x4_t __attribute__((ext_vector_type(4)));
typedef int i32x8_t __attribute__((ext_vector_type(8)));

constexpr int D = 2048, SEQ = 4096, BATCH = 4, M = BATCH * SEQ;
constexpr int NIN = 14848;
constexpr int C_CB = 0, C_CC = 1024, C_CH = 2048, C_Q = 3072, C_K = 4608, C_V = 6144, C_PU = 7680, C_G = 8704;
constexpr int C_P8 = INPROJ_V8 == 2 ? C_Q : (INPROJ_V8 == 1 ? C_V : C_PU);
constexpr int NV8 = (C_PU - C_P8) / 256, NR8 = INPROJ_V8 == 2 ? (C_V - C_Q) / 256 : 0;
constexpr int N_BF = C_G - NV8 * 256, N_F8 = NIN - N_BF;
constexpr int FF = 7168, NEXP = 8;
constexpr int KBR = 2560;
constexpr float LN_EPS = 1e-5f;
constexpr float ALPHA = 1.41421356237309515f;
constexpr float F8_XS = 8.f, F8_WGS = 64.f, F8_HS = 8.f, F8_WDS = 256.f;
constexpr int MOE_MAXT = 136;

constexpr size_t MiB = 1u << 20;
constexpr size_t WS_CTL = 0, CTL_ZERO_BYTES = 1 * MiB;
constexpr size_t WS_ROT = 1 * MiB;
constexpr size_t WS_LIST = 2 * MiB;
constexpr size_t WS_INFO = WS_LIST + 512 * 1024;
constexpr size_t WS_LSE = 4 * MiB;
constexpr size_t WS_WL = 5 * MiB, WL_STRIDE = 77 * MiB;
constexpr size_t WL_WIN = 0, WL_WG8 = 40 * MiB, WL_WBR = 58 * MiB, WL_WO = 68 * MiB, WL_PM = 76 * MiB;
constexpr size_t WS_FFN0 = WS_WL + 2 * WL_STRIDE;
constexpr size_t FFN_WGU = 0, FFN_WD = 56 * MiB, FFN_STRIDE = 84 * MiB;
constexpr size_t WS_MOE = WS_FFN0 + FFN_STRIDE;
constexpr size_t WS_XB = WS_MOE + 8 * FFN_STRIDE;
constexpr size_t WS_BIG = WS_XB + 64 * MiB;
constexpr size_t BIG_PROJ = 0, BIG_ABR = 464 * MiB, BIG_MRG = 544 * MiB, BIG_BYTES = 608 * MiB;
constexpr size_t WS_ATT = WS_BIG + BIG_BYTES;
constexpr size_t WS_Y = WS_ATT + 48 * MiB;
constexpr size_t Y_SCR = 0, Y_POOLED = 64 * MiB;
constexpr size_t WS_PART = WS_Y + 136 * MiB;
constexpr size_t WS_END = WS_PART + 64 * MiB;
static_assert((size_t)MOE_MAXT * 256 * FF * 2 <= BIG_BYTES, "h overlay");
constexpr int CW_TMO = 0, CW_CODE = 1, CW_BAR = 4096, CW_CNT = 8192, CW_TT = 16384;

constexpr int RING_BYTES = 131072, LDSCTL_OFF = RING_BYTES, MISC_OFF = LDSCTL_OFF + 320, TAB_OFF = LDSCTL_OFF + 512;
constexpr int LDS_BYTES = 147456;

#define RLX_AGENT __ATOMIC_RELAXED, __HIP_MEMORY_SCOPE_AGENT
#define LDS_WAIT() asm volatile("s_waitcnt lgkmcnt(0)" ::: "memory")
#define VM_WAIT() asm volatile("s_waitcnt vmcnt(0)" ::: "memory")
#ifndef CVT_NATIVE
#define CVT_NATIVE 0
#endif
typedef float cvt_f2_t __attribute__((ext_vector_type(2))); typedef __bf16 cvt_b2_t __attribute__((ext_vector_type(2)));
__device__ __forceinline__ unsigned cvt_pk_bf16(float lo, float hi) {
#if CVT_NATIVE
    const cvt_f2_t v = {lo, hi}; return __builtin_bit_cast(unsigned, __builtin_convertvector(v, cvt_b2_t));
#else
    unsigned r; asm volatile("s_nop 0\n\tv_cvt_pk_bf16_f32 %0, %1, %2" : "=v"(r) : "v"(lo), "v"(hi)); return r;
#endif
}
__device__ __forceinline__ float bflo(unsigned w) { return __uint_as_float(w << 16); }
__device__ __forceinline__ float bfhi(unsigned w) { return __uint_as_float(w & 0xffff0000u); }
__device__ __forceinline__ void unpack8(const u32x4 w, float (&f)[8]) { f[0] = bflo(w.x); f[1] = bfhi(w.x); f[2] = bflo(w.y); f[3] = bfhi(w.y); f[4] = bflo(w.z); f[5] = bfhi(w.z); f[6] = bflo(w.w); f[7] = bfhi(w.w); }
__device__ __forceinline__ u32x4 pack8(const float (&f)[8]) { u32x4 w; w.x = cvt_pk_bf16(f[0], f[1]); w.y = cvt_pk_bf16(f[2], f[3]); w.z = cvt_pk_bf16(f[4], f[5]); w.w = cvt_pk_bf16(f[6], f[7]); return w; }
__device__ __forceinline__ float fast_sigmoid(float x) { return __builtin_amdgcn_rcpf(1.0f + __builtin_amdgcn_exp2f(-1.4426950408889634f * x)); }
#ifndef POLY_SIGMOID
#define POLY_SIGMOID 0
#endif
#ifndef POLY_GATES
#define POLY_GATES POLY_SIGMOID
#endif
__device__ __forceinline__ f32x2 sigmoid_pk4(f32x2 x) {
    f32x2 y; y.x = __builtin_amdgcn_fmed3f(x.x, -7.0f, 7.0f); y.y = __builtin_amdgcn_fmed3f(x.y, -7.0f, 7.0f);
    const f32x2 z = y * y; f32x2 p = z * 8.0129337452e-08f + (-1.0775084697e-05f); p = p * z + 5.4888180593e-04f; p = p * z + (-1.3868919285e-02f); p = p * z + 2.3951370939e-01f;
    return p * y + 0.5f; }
__device__ __forceinline__ f32x2 sigmoid_pk5(f32x2 x) {
    f32x2 y; y.x = __builtin_amdgcn_fmed3f(x.x, -8.0f, 8.0f); y.y = __builtin_amdgcn_fmed3f(x.y, -8.0f, 8.0f);
    const f32x2 z = y * y; f32x2 p = z * (-1.0450863819e-09f) + 2.1221353673e-07f; p = p * z + (-1.6824298276e-05f); p = p * z + 6.6947638680e-04f; p = p * z + (-1.4838334535e-02f); p = p * z + 2.4161688857e-01f;
    return p * y + 0.5f; }
__device__ __forceinline__ float wave_sum(float v) {
#pragma unroll
    for (int o = 1; o < 64; o <<= 1) v += __shfl_xor(v, o);
    return v;
}

namespace pg8 {
#define PG8_LAS __attribute__((address_space(3)))
constexpr int BM = 256, BK = 64, HALF = 128, HTB = HALF * BK * 2, STAGE_BYTES = 8 * HTB;
__host__ __device__ __forceinline__ int lds_byte(int r, int c) { const int st = (r >> 4) * 2 + (c >> 5), rr = r & 15, cc = c & 31, ob = rr * 64 + cc * 2; return st * 1024 + (ob ^ (((ob >> 9) & 1) << 5)); }
__host__ __device__ __forceinline__ void stage_rc(int b, int& R, int& C) { const int st = b / 1024, sb = b % 1024, swz = sb ^ (((sb >> 9) & 1) << 5); R = (st >> 1) * 16 + swz / 64; C = (st & 1) * 32 + (swz % 64) / 2; }
__host__ __device__ __forceinline__ int perm32(int rho) { const int n = rho >> 4, i = rho & 15; return 8 * (i >> 2) + 4 * n + (i & 3); }

struct Unit { const char* A; const char* B; int nt; int pm, pn, aux; };

template <class Epi, class Sched, bool GATHER, bool ALIGN_EPI, bool SP2, bool FP8 = false>
__device__ __forceinline__ void gemm_phase(PG8_LAS unsigned char* lds, const int lda, const int ldb, const Sched& S, const Epi& E) {
    int tid_ = threadIdx.x; asm volatile("" : "+v"(tid_));
    const int tid = tid_, wid = __builtin_amdgcn_readfirstlane(tid >> 6), lane = tid & 63, wr = wid >> 2, wc = wid & 3, fr = lane & 15, fq = lane >> 4;
    unsigned voffB[2], vA[2][2], vN[2][2]; int RA[2], CA[2];
#pragma unroll
    for (int i = 0; i < 2; ++i) { int R, C; stage_rc(tid * 16 + i * 8192, R, C); const int Rb = Epi::PERM ? ((R & ~31) + perm32(R & 31)) : R;
        RA[i] = R; CA[i] = C; voffB[i] = (unsigned)(Rb * ldb + C) * 2u;
#pragma unroll
        for (int h = 0; h < 2; ++h) { vA[h][i] = (unsigned)((h * HALF + R) * lda + C) * 2u; vN[h][i] = vA[h][i]; } }
    const size_t kstep = (size_t)(BK * 2);
    const size_t hstepB = (size_t)HALF * ldb * 2;
    const unsigned ldsw = (unsigned)wid * 1024u;
    const int aoff = lds_byte(wr * 64 + fr, fq * 8), boff = lds_byte(wc * 32 + fr, fq * 8);
#define PG8_SA(b, h) (((b) * 2 + (h)) * HTB)
#define PG8_SB(b, h) ((4 + (b) * 2 + (h)) * HTB)
#define PG8_STAGE_B(bufoff, gbase) do { _Pragma("unroll") for (int _i = 0; _i < 2; ++_i) \
        __builtin_amdgcn_global_load_lds((const unsigned*)((const char*)(gbase) + voffB[_i]), (PG8_LAS unsigned*)(lds + (bufoff) + ldsw + _i * 8192), 16, 0, 0); } while (0)
#define PG8_STAGE_A(bufoff, gbase, vo) do { _Pragma("unroll") for (int _i = 0; _i < 2; ++_i) \
        __builtin_amdgcn_global_load_lds((const unsigned*)((const char*)(gbase) + (vo)[_i]), (PG8_LAS unsigned*)(lds + (bufoff) + ldsw + _i * 8192), 16, 0, 0); } while (0)
#define PG8_LDA(dst, b, h) do { if constexpr (FP8) { _Pragma("unroll") for (int m = 0; m < 4; ++m) { const i32x4_t lo_ = *(const PG8_LAS i32x4_t*)(lds + PG8_SA(b, h) + aoff + m * 2048), hi_ = *(const PG8_LAS i32x4_t*)(lds + PG8_SA(b, h) + aoff + m * 2048 + 1024); A8[m] = __builtin_shufflevector(lo_, hi_, 0, 1, 2, 3, 4, 5, 6, 7); } } \
        else { _Pragma("unroll") for (int m = 0; m < 4; ++m) _Pragma("unroll") for (int k = 0; k < 2; ++k) dst[m][k] = *(const PG8_LAS bf16x8*)(lds + PG8_SA(b, h) + aoff + m * 2048 + k * 1024); } } while (0)
#define PG8_LDB(dst, b, h) do { if constexpr (FP8) { _Pragma("unroll") for (int n = 0; n < 2; ++n) { const i32x4_t lo_ = *(const PG8_LAS i32x4_t*)(lds + PG8_SB(b, h) + boff + n * 2048), hi_ = *(const PG8_LAS i32x4_t*)(lds + PG8_SB(b, h) + boff + n * 2048 + 1024); dst##_8[n] = __builtin_shufflevector(lo_, hi_, 0, 1, 2, 3, 4, 5, 6, 7); } } \
        else { _Pragma("unroll") for (int n = 0; n < 2; ++n) _Pragma("unroll") for (int k = 0; k < 2; ++k) dst[n][k] = *(const PG8_LAS bf16x8*)(lds + PG8_SB(b, h) + boff + n * 2048 + k * 1024); } } while (0)
#define PG8_MMA(ai, bj, At, Bt) do { __builtin_amdgcn_s_setprio(1); if constexpr (FP8) { _Pragma("unroll") for (int m = 0; m < 4; ++m) _Pragma("unroll") for (int n = 0; n < 2; ++n) \
        asm volatile("v_mfma_scale_f32_16x16x128_f8f6f4 %0, %1, %2, %0, %3, %3 op_sel_hi:[0,0,0]" : "+v"(acc[ai][bj][m][n]) : "v"(Bt##_8[n]), "v"(A8[m]), "v"(sc8)); } \
        else { _Pragma("unroll") for (int m = 0; m < 4; ++m) _Pragma("unroll") for (int n = 0; n < 2; ++n) _Pragma("unroll") for (int k = 0; k < 2; ++k) \
        acc[ai][bj][m][n] = __builtin_amdgcn_mfma_f32_16x16x32_bf16(Bt[n][k], At[m][k], acc[ai][bj][m][n], 0, 0, 0); } __builtin_amdgcn_s_setprio(0); } while (0)
#define PG8_WAIT_V(n) asm volatile("s_waitcnt vmcnt(" #n ")" ::: "memory")
#define PG8_WAIT_L(n) asm volatile("s_waitcnt lgkmcnt(" #n ")" ::: "memory")
#define PG8_BAR __builtin_amdgcn_s_barrier()
#define PG8_SCHED __builtin_amdgcn_sched_barrier(0)
#define PG8_ROWS(dst, u) do { _Pragma("unroll") for (int _h = 0; _h < 2; ++_h) _Pragma("unroll") for (int _i = 0; _i < 2; ++_i) dst[_h][_i] = S.row_off(u, _h * HALF + RA[_i]) + (unsigned)CA[_i] * 2u; } while (0)
    Unit cur, nxt; int ui = 0;
    if (!S.next(0, cur)) return;
    f32x4 acc[2][2][4][2];
#pragma unroll
    for (int a = 0; a < 2; ++a)
#pragma unroll
        for (int b = 0; b < 2; ++b)
#pragma unroll
            for (int m = 0; m < 4; ++m)
#pragma unroll
                for (int n = 0; n < 2; ++n) acc[a][b][m][n] = (f32x4){0.f, 0.f, 0.f, 0.f};
    bf16x8 At[4][2], B0[2][2], B1[2][2]; i32x8_t A8[4], B0_8[2], B1_8[2];
    int sc8 = 0x7f7f7f7f; asm volatile("" : "+v"(sc8));
    const char* cA = cur.A; const char* cB = cur.B; int nt = cur.nt; asm volatile("" : "+s"(nt));
    if constexpr (GATHER) { PG8_ROWS(vA, cur); }
    S.a_ready(cur);
    if constexpr (SP2) {
        PG8_STAGE_B(PG8_SB(0, 0), cB); PG8_STAGE_B(PG8_SB(0, 1), cB + hstepB); PG8_STAGE_A(PG8_SA(0, 0), cA, vA[0]); PG8_STAGE_A(PG8_SA(0, 1), cA, vA[1]);
        if (wr == 1) PG8_BAR;
        PG8_WAIT_V(2); PG8_BAR;
        PG8_STAGE_B(PG8_SB(1, 0), cB + kstep); PG8_STAGE_A(PG8_SA(1, 0), cA + kstep, vA[0]); PG8_STAGE_B(PG8_SB(1, 1), cB + hstepB + kstep);
        PG8_WAIT_V(6); PG8_BAR;
    } else {
        PG8_STAGE_B(PG8_SB(0, 0), cB); PG8_STAGE_A(PG8_SA(0, 0), cA, vA[0]); PG8_STAGE_B(PG8_SB(0, 1), cB + hstepB); PG8_STAGE_A(PG8_SA(0, 1), cA, vA[1]);
        if (wr == 1) PG8_BAR;
        PG8_WAIT_V(4); PG8_BAR;
        PG8_STAGE_B(PG8_SB(1, 0), cB + kstep); PG8_STAGE_A(PG8_SA(1, 0), cA + kstep, vA[0]); PG8_STAGE_B(PG8_SB(1, 1), cB + hstepB + kstep);
        PG8_WAIT_V(6); PG8_BAR;
    }
    for (;;) {
        const bool has_next = S.next(ui + 1, nxt);
        const char* nA = has_next ? nxt.A : cA; const char* nB = has_next ? nxt.B : cB;
        if constexpr (GATHER) { if (has_next) { PG8_ROWS(vN, nxt); } }
#pragma clang loop unroll(disable)
        for (int t = 0; t < nt; t += 2) {
            const bool last = (t == nt - 2);
            const char* a1 = cA + (size_t)(t + 1) * kstep;
            const char* a2 = last ? nA : cA + (size_t)(t + 2) * kstep; const char* b2 = last ? nB : cB + (size_t)(t + 2) * kstep;
            const char* a3 = a2 + kstep; const char* b3 = b2 + kstep;
            unsigned v2[2][2];
#pragma unroll
            for (int h = 0; h < 2; ++h)
#pragma unroll
                for (int i = 0; i < 2; ++i) v2[h][i] = (GATHER && last) ? vN[h][i] : vA[h][i];
            if (last && has_next) S.a_ready(nxt);
            if constexpr (SP2) {
            PG8_LDB(B0, 0, 0); PG8_LDB(B1, 0, 1); PG8_SCHED; PG8_LDA(At, 0, 0); PG8_STAGE_A(PG8_SA(1, 1), a1, vA[1]);
            PG8_WAIT_V(8); PG8_WAIT_L(0); PG8_BAR; PG8_MMA(0, 0, At, B0); PG8_MMA(0, 1, At, B1); PG8_BAR; PG8_SCHED;
            PG8_LDA(At, 0, 1); PG8_STAGE_B(PG8_SB(0, 0), b2); PG8_STAGE_B(PG8_SB(0, 1), b2 + hstepB); PG8_STAGE_A(PG8_SA(0, 0), a2, v2[0]);
            PG8_WAIT_V(8); PG8_WAIT_L(0); PG8_BAR; PG8_MMA(1, 0, At, B0); PG8_MMA(1, 1, At, B1); PG8_BAR; PG8_SCHED;
            PG8_LDB(B0, 1, 0); PG8_LDB(B1, 1, 1); PG8_SCHED; PG8_LDA(At, 1, 0); PG8_STAGE_A(PG8_SA(0, 1), a2, v2[1]);
            PG8_WAIT_V(8); PG8_WAIT_L(0); PG8_BAR; PG8_MMA(0, 0, At, B0); PG8_MMA(0, 1, At, B1); PG8_BAR; PG8_SCHED;
            PG8_LDA(At, 1, 1); PG8_STAGE_B(PG8_SB(1, 0), b3); PG8_STAGE_B(PG8_SB(1, 1), b3 + hstepB); PG8_STAGE_A(PG8_SA(1, 0), a3, v2[0]);
            PG8_WAIT_V(8); PG8_WAIT_L(0); PG8_BAR; PG8_MMA(1, 0, At, B0); PG8_MMA(1, 1, At, B1); PG8_BAR; PG8_SCHED;
            } else {
            PG8_LDB(B0, 0, 0); PG8_SCHED; PG8_LDA(At, 0, 0); PG8_STAGE_A(PG8_SA(1, 1), a1, vA[1]);
            PG8_WAIT_L(8); PG8_BAR; PG8_WAIT_L(0); PG8_MMA(0, 0, At, B0); PG8_BAR; PG8_SCHED;
            PG8_LDB(B1, 0, 1); PG8_STAGE_B(PG8_SB(0, 0), b2);
            PG8_BAR; PG8_WAIT_L(0); PG8_MMA(0, 1, At, B1); PG8_BAR;
            PG8_LDA(At, 0, 1); PG8_STAGE_A(PG8_SA(0, 0), a2, v2[0]);
            PG8_BAR; PG8_WAIT_L(0); PG8_MMA(1, 0, At, B0); PG8_BAR; PG8_SCHED;
            PG8_STAGE_B(PG8_SB(0, 1), b2 + hstepB);
            PG8_WAIT_V(6); PG8_BAR; PG8_MMA(1, 1, At, B1); PG8_BAR;
            PG8_LDB(B0, 1, 0); PG8_SCHED; PG8_LDA(At, 1, 0); PG8_STAGE_A(PG8_SA(0, 1), a2, v2[1]);
            PG8_WAIT_L(8); PG8_BAR; PG8_WAIT_L(0); PG8_MMA(0, 0, At, B0); PG8_BAR; PG8_SCHED;
            PG8_LDB(B1, 1, 1); PG8_STAGE_B(PG8_SB(1, 0), b3);
            PG8_BAR; PG8_WAIT_L(0); PG8_MMA(0, 1, At, B1); PG8_BAR;
            PG8_LDA(At, 1, 1); PG8_STAGE_A(PG8_SA(1, 0), a3, v2[0]);
            PG8_BAR; PG8_WAIT_L(0); PG8_MMA(1, 0, At, B0); PG8_BAR; PG8_SCHED;
            PG8_STAGE_B(PG8_SB(1, 1), b3 + hstepB);
            PG8_WAIT_V(6); PG8_BAR; PG8_MMA(1, 1, At, B1); PG8_BAR;
            }
        }
        if constexpr (ALIGN_EPI) { if (wr == 0) PG8_BAR; }
        if constexpr (FP8) { asm volatile("s_nop 15\n\ts_nop 15" ::: "memory");
#pragma unroll
            for (int a = 0; a < 2; ++a)
#pragma unroll
                for (int b = 0; b < 2; ++b)
#pragma unroll
                    for (int m = 0; m < 4; ++m)
#pragma unroll
                        for (int n = 0; n < 2; ++n) asm volatile("" : "+v"(acc[a][b][m][n])); }
        E(acc, cur, wr, wc, fr, fq);
        if (!has_next) break;
        if (!E.keep(cur)) {
#pragma unroll
        for (int a = 0; a < 2; ++a)
#pragma unroll
            for (int b = 0; b < 2; ++b)
#pragma unroll
                for (int m = 0; m < 4; ++m)
#pragma unroll
                    for (int n = 0; n < 2; ++n) acc[a][b][m][n] = (f32x4){0.f, 0.f, 0.f, 0.f};
        }
        cur = nxt; cA = nA; cB = nB; nt = nxt.nt; ++ui;
        if constexpr (GATHER) {
#pragma unroll
            for (int h = 0; h < 2; ++h)
#pragma unroll
                for (int i = 0; i < 2; ++i) vA[h][i] = vN[h][i];
        }
        if constexpr (ALIGN_EPI) { if (wr == 1) PG8_BAR; }
    }
    PG8_WAIT_V(0);
    if constexpr (!ALIGN_EPI) { if (wr == 0) PG8_BAR; }
    PG8_BAR;
#undef PG8_SA
#undef PG8_SB
#undef PG8_STAGE_A
#undef PG8_STAGE_B
#undef PG8_LDA
#undef PG8_LDB
#undef PG8_MMA
#undef PG8_WAIT_V
#undef PG8_WAIT_L
#undef PG8_BAR
#undef PG8_SCHED
#undef PG8_ROWS
}

__device__ __forceinline__ bool tile_of(int L, int nM, int nN, int& pm, int& pn) {
    const int nwg = nM * nN; if (L >= nwg) return false;
    int wgid = L; { const int q = nwg / 8, r = nwg % 8, xcd = wgid % 8, off = wgid / 8; wgid = (xcd < r ? xcd * (q + 1) : r * (q + 1) + (xcd - r) * q) + off; }
    const int nig = GEMM_WGM * nN, gid = wgid / nig, fm = gid * GEMM_WGM, gsz = (nM - fm) < GEMM_WGM ? (nM - fm) : GEMM_WGM;
    pm = fm + ((wgid % nig) % gsz); pn = (wgid % nig) / gsz; return true;
}
}

#define XB_TMO      128
#define XB_XCNT(j)  (256  + 64 * (j))
#define XB_XSUB(j)  (1280 + 64 * (j))
#define XB_XGEN(j)  (2304 + 64 * (j))
#define XB_TOP      3328
#define XB_TOPGEN   3392
#define XCD_BAR_WORDS 3456
#define XB_SPIN_CAP (1u << 18)
__device__ __forceinline__ unsigned xb_ld(unsigned* p)              { return __hip_atomic_load(p, __ATOMIC_RELAXED, __HIP_MEMORY_SCOPE_AGENT); }
__device__ __forceinline__ unsigned xb_add(unsigned* p, unsigned v) { return __hip_atomic_fetch_add(p, v, __ATOMIC_RELAXED, __HIP_MEMORY_SCOPE_AGENT); }
__device__ __forceinline__ unsigned xb_xcc_id() { return (unsigned)__builtin_amdgcn_s_getreg((3 << 11) | 20) & 0xFu; }
#define XB_SPIN(cond, bar) do { unsigned _sp = 0; while (cond) { __builtin_amdgcn_s_sleep(1); \
    if ((++_sp & 255u) == 0u) { if (xb_ld(&(bar)[XB_TMO])) break; if (_sp > XB_SPIN_CAP) { atomicAdd(&(bar)[XB_TMO], 1u); break; } } } } while (0)
struct XcdBarrier { unsigned* bar; unsigned x; volatile LAS unsigned* st; };
__device__ __forceinline__ XcdBarrier xcd_barrier_post(unsigned* bar, volatile LAS unsigned* st) {
    XcdBarrier b; b.bar = bar; b.x = xb_xcc_id(); b.st = st;
    if (threadIdx.x == 0) (void)xb_add(&bar[XB_XCNT(b.x)], 1u);
    return b;
}
__device__ __forceinline__ void xcd_barrier_complete(unsigned* bar, unsigned x, unsigned& nloc, unsigned& nx) {
    const unsigned G = gridDim.x * gridDim.y * gridDim.z;
    unsigned sum, cnt, mine, sp = 0u;
    for (;;) {
        sum = 0u; cnt = 0u; mine = 0u;
#pragma unroll
        for (unsigned j = 0; j < 16; ++j) { const unsigned c = xb_ld(&bar[XB_XCNT(j)]); sum += c; cnt += (c > 0u) ? 1u : 0u; mine = (j == x) ? c : mine; }
        if (sum == G) break;
        __builtin_amdgcn_s_sleep(1);
        if ((++sp & 255u) == 0u) { if (xb_ld(&bar[XB_TMO])) break; if (sp > XB_SPIN_CAP) { atomicAdd(&bar[XB_TMO], 1u); break; } }
    }
    nloc = mine > 0u ? mine : 1u; nx = cnt > 0u ? cnt : 1u;
}
__device__ __forceinline__ void xcd_barrier(const XcdBarrier& b) {
    asm volatile("s_waitcnt vmcnt(0)" ::: "memory");
    __syncthreads();
    if (threadIdx.x == 0) {
        unsigned* bar = b.bar;
        __builtin_amdgcn_s_waitcnt(0);
        unsigned nloc = b.st[0], nx = b.st[1];
        if (nloc == 0u) { xcd_barrier_complete(bar, b.x, nloc, nx); b.st[0] = nloc; b.st[1] = nx; }
        const unsigned old = xb_add(&bar[XB_XSUB(b.x)], 1u);
        const unsigned gen = old / nloc;
        if (old + 1u == (gen + 1u) * nloc) {
            __builtin_amdgcn_fence(__ATOMIC_RELEASE, "agent");
            asm volatile("s_waitcnt vmcnt(0)" ::: "memory");
            const unsigned og = xb_add(&bar[XB_TOP], 1u);
            const unsigned tg = og / nx;
            if (og + 1u == (tg + 1u) * nx) xb_add(&bar[XB_TOPGEN], 1u);
            else XB_SPIN(xb_ld(&bar[XB_TOPGEN]) == tg, bar);
            __builtin_amdgcn_fence(__ATOMIC_ACQUIRE, "agent");
            xb_add(&bar[XB_XGEN(b.x)], 1u);
            asm volatile("s_waitcnt vmcnt(0)" ::: "memory");
        } else {
            XB_SPIN(xb_ld(&bar[XB_XGEN(b.x)]) == gen, bar);
            __builtin_amdgcn_fence(__ATOMIC_ACQUIRE, "agent");
            asm volatile("s_waitcnt vmcnt(0)" ::: "memory");
        }
    }
    __syncthreads();
}

struct Args { const float* in[32]; float* out; unsigned char* ws; float inv_freq[16]; int ph_lo, ph_hi, pad0, pad1; };

using pg8::Unit;
struct DenseSched {
    const char* A; const char* B; int nM, nN, nt, G, c; size_t strideA, strideB; bool dum = false;
    int nlo = 0, nhi = 0;
    __device__ __forceinline__ bool next(int i, Unit& u) const { int pm, pn; int L = i * G + c;
        if ((nlo | nhi) > 0) { const int nmin = nlo < nhi ? nlo : nhi; if (i >= (c < 128 ? nlo : nhi)) return false; if (i >= nmin) L = nmin * G + (i - nmin) * 128 + (c & 127); }
        if (!pg8::tile_of(L, nM, nN, pm, pn)) return false; if (dum) { pm &= 1; pn &= 1; }
        u.A = A + (size_t)pm * strideA; u.B = B + (size_t)pn * strideB; u.nt = nt; u.pm = pm; u.pn = pn; u.aux = 0; return true; }
    __device__ __forceinline__ void a_ready(const Unit&) const {}
    __device__ __forceinline__ unsigned row_off(const Unit&, int) const { return 0u; }
};
struct BranchSched {
    const char* A; const char* B; int G, c;
    __device__ __forceinline__ bool next(int i, Unit& u) const { const int ti = i / 3, seg = i - 3 * ti; int pm, pn; if (!pg8::tile_of(ti * G + c, M / 256, D / 256, pm, pn)) return false;
        const int koff = seg == 0 ? 0 : (seg == 1 ? 1024 : 1536);
        u.A = A + ((size_t)pm * 256 * KBR + koff) * 2; u.B = B + ((size_t)pn * 256 * KBR + koff) * 2; u.nt = seg == 1 ? 8 : 16; u.pm = pm; u.pn = pn; u.aux = seg; return true; }
    __device__ __forceinline__ void a_ready(const Unit&) const {}
    __device__ __forceinline__ unsigned row_off(const Unit&, int) const { return 0u; }
};
struct PoolMixSched {
    const char* A; const char* B; int G, c;
    __device__ __forceinline__ bool next(int i, Unit& u) const { const int L = i * G + c; if (L >= 256) return false; const int pm = L >> 2, g = L & 3;
        u.A = A + ((size_t)pm * 256 * 1024 + g * 256) * 2; u.B = B + (size_t)g * 256 * 2; u.nt = 4; u.pm = pm; u.pn = g; u.aux = 0; return true; }
    __device__ __forceinline__ void a_ready(const Unit&) const {}
    __device__ __forceinline__ unsigned row_off(const Unit&, int) const { return 0u; }
};
struct MoeSched {
    const char* A; const char* B; const volatile LAS int* tab; const int* list; int nN, nt, G, c; size_t strideA, strideBe, strideBn; bool gather; unsigned rowbytes; int split = 0;
    __device__ __forceinline__ int tb(int k) const { return __builtin_amdgcn_readfirstlane(tab[k]); }
    __device__ __forceinline__ bool next(int i, Unit& u) const { const int NT = tb(8); int pm, pn; int L = i * G + c, sl = 0, tj = 0, ntu = nt;
        if (split) { const int U = NT * nN, full = U >> 8, R = U & 255;
            if (R > 0 && R <= 64 && i >= full) { if (i > full || c >= 4 * R) return false; sl = (c >= R ? 1 : 0) + (c >= 2 * R ? 1 : 0) + (c >= 3 * R ? 1 : 0); tj = c - sl * R + 1; L = (full << 8) + tj - 1; ntu = nt >> 2; } }
        if (!pg8::tile_of(L, NT, nN, pm, pn)) return false;
        int e = 0;
#pragma unroll
        for (int k = 1; k < 8; ++k) e += (pm >= tb(k)) ? 1 : 0;
        const size_t ko = (size_t)(sl * ntu) * 128;
        u.A = (gather ? A : A + (size_t)pm * strideA) + ko; u.B = B + (size_t)e * strideBe + (size_t)pn * strideBn + ko; u.nt = ntu; u.pm = pm; u.pn = pn; u.aux = e | (sl << 4) | (tj << 8); return true; }
    __device__ __forceinline__ void a_ready(const Unit&) const {}
    __device__ __forceinline__ unsigned row_off(const Unit& u, int r) const {
        const int e = u.aux, r0 = (u.pm - tb(e)) * 256, cnt = tb(16 + e); const int rr = (r0 + r < cnt) ? r0 + r : r0;
        return (unsigned)list[e * M + rr] * rowbytes; }
};

struct EpiInProj {
    static constexpr bool PERM = true;
    __device__ __forceinline__ bool keep(const Unit&) const { return false; }
    bf16* O; const float* cosT; const float* sinT;
    __device__ __forceinline__ void operator()(f32x4 (&acc)[2][2][4][2], const Unit& u, int wr, int wc, int fr, int fq) const {
        const int row0 = u.pm * 256 + wr * 64 + fr, col0 = (u.pn + ((GATES_FP8_COMPUTE && !GATES_TEST && u.pn >= C_P8 / 256) ? NV8 : 0)) * 256 + wc * 32 + 8 * fq;
        const int mode = (u.pn >= 34) ? 2 : ((u.pn >= 12 && u.pn < 24 && !(GATES_FP8_COMPUTE && !GATES_TEST && INPROJ_V8 == 2)) ? 1 : ((CONV_FUSE && u.pn >= 4 && u.pn < 12) ? 3 : 0));
        if (mode == 3) {
#pragma unroll
            for (int ai = 0; ai < 2; ++ai)
#pragma unroll
                for (int m = 0; m < 4; ++m) { const f32x4 v0 = acc[ai][0][m][0] * acc[ai][1][m][0], v1 = acc[ai][0][m][1] * acc[ai][1][m][1];
                    u32x4 w; w.x = cvt_pk_bf16(v0[0], v0[1]); w.y = cvt_pk_bf16(v0[2], v0[3]); w.z = cvt_pk_bf16(v1[0], v1[1]); w.w = cvt_pk_bf16(v1[2], v1[3]);
                    *(u32x4*)(O + (size_t)(row0 + ai * 128 + m * 16) * NIN + C_CC + (u.pn - 4) * 128 + wc * 32 + 8 * fq) = w; }
            return; }
#pragma unroll
        for (int ai = 0; ai < 2; ++ai)
#pragma unroll
            for (int m = 0; m < 4; ++m) { const int row = row0 + ai * 128 + m * 16; bf16* rowp = O + (size_t)row * NIN + col0;
                f32x4 c0 = {1.f, 1.f, 1.f, 1.f}, c1 = c0, s0 = {0.f, 0.f, 0.f, 0.f}, s1 = s0;
                if (mode == 1 && wc == 0) { const int pos = row & (SEQ - 1), j0 = 8 * (fq & 1);
                    c0 = *(const f32x4*)(cosT + pos * 16 + j0); c1 = *(const f32x4*)(cosT + pos * 16 + j0 + 4);
                    s0 = *(const f32x4*)(sinT + pos * 16 + j0); s1 = *(const f32x4*)(sinT + pos * 16 + j0 + 4);
                    if (fq < 2) { s0 = -s0; s1 = -s1; } }
#pragma unroll
                for (int bj = 0; bj < 2; ++bj) { f32x4 v0 = acc[ai][bj][m][0], v1 = acc[ai][bj][m][1];
                    if (mode == 1 && wc == 0) { f32x4 o0, o1;
#pragma unroll
                        for (int j = 0; j < 4; ++j) { o0[j] = __shfl_xor(v0[j], 32); o1[j] = __shfl_xor(v1[j], 32); }
                        v0 = v0 * c0 + o0 * s0; v1 = v1 * c1 + o1 * s1; }
                    if (mode == 2) {
#pragma unroll
                        for (int j = 0; j < 4; ++j) { v0[j] = fast_sigmoid(v0[j]); v1[j] = fast_sigmoid(v1[j]); } }
                    u32x4 w; w.x = cvt_pk_bf16(v0[0], v0[1]); w.y = cvt_pk_bf16(v0[2], v0[3]); w.z = cvt_pk_bf16(v1[0], v1[1]); w.w = cvt_pk_bf16(v1[2], v1[3]);
                    *(u32x4*)(rowp + bj * 128) = w; }
                asm volatile("" ::: "memory"); }
    }
};
struct EpiGate8 {
    static constexpr bool PERM = true;
    __device__ __forceinline__ bool keep(const Unit&) const { return false; }
    bf16* O; const float* cosT; const float* sinT;
    __device__ __forceinline__ void operator()(f32x4 (&acc)[2][2][4][2], const Unit& u, int wr, int wc, int fr, int fq) const {
        const int row0 = u.pm * 256 + wr * 64 + fr, col0 = (u.pn < NV8 ? C_P8 + u.pn * 256 : C_G + (u.pn - NV8) * 256) + wc * 32 + 8 * fq; const float is = -1.4426950408889634f / (F8_XS * F8_WGS);
        if (u.pn < NV8) {
            const float f = 1.0f / (F8_XS * F8_WGS); const bool rot = u.pn < NR8 && wc == 0;
#pragma unroll
            for (int ai = 0; ai < 2; ++ai)
#pragma unroll
                for (int m = 0; m < 4; ++m) { const int row = row0 + ai * 128 + m * 16; bf16* rowp = O + (size_t)row * NIN + col0;
                    f32x4 c0 = {1.f, 1.f, 1.f, 1.f}, c1 = c0, s0 = {0.f, 0.f, 0.f, 0.f}, s1 = s0;
                    if (rot) { const int pos = row & (SEQ - 1), j0 = 8 * (fq & 1);
                        c0 = *(const f32x4*)(cosT + pos * 16 + j0); c1 = *(const f32x4*)(cosT + pos * 16 + j0 + 4);
                        s0 = *(const f32x4*)(sinT + pos * 16 + j0); s1 = *(const f32x4*)(sinT + pos * 16 + j0 + 4);
                        if (fq < 2) { s0 = -s0; s1 = -s1; } }
#pragma unroll
                    for (int bj = 0; bj < 2; ++bj) { f32x4 v0 = acc[ai][bj][m][0] * f, v1 = acc[ai][bj][m][1] * f;
                        if (rot) { f32x4 o0, o1;
#pragma unroll
                            for (int j = 0; j < 4; ++j) { o0[j] = __shfl_xor(v0[j], 32); o1[j] = __shfl_xor(v1[j], 32); }
                            v0 = v0 * c0 + o0 * s0; v1 = v1 * c1 + o1 * s1; }
                        u32x4 w; w.x = cvt_pk_bf16(v0[0], v0[1]); w.y = cvt_pk_bf16(v0[2], v0[3]); w.z = cvt_pk_bf16(v1[0], v1[1]); w.w = cvt_pk_bf16(v1[2], v1[3]);
                        if (O) *(u32x4*)(rowp + bj * 128) = w; }
                    asm volatile("" ::: "memory"); }
            return; }
#pragma unroll
        for (int ai = 0; ai < 2; ++ai)
#pragma unroll
            for (int m = 0; m < 4; ++m) { bf16* rowp = O + (size_t)(row0 + ai * 128 + m * 16) * NIN + col0;
#pragma unroll
                for (int bj = 0; bj < 2; ++bj) { f32x4 v0 = acc[ai][bj][m][0], v1 = acc[ai][bj][m][1];
#pragma unroll
                    for (int j = 0; j < 4; j += 2) {
#if POLY_GATES
                        const f32x2 a0 = sigmoid_pk5((f32x2){v0[j], v0[j + 1]} * (1.0f / (F8_XS * F8_WGS))), a1 = sigmoid_pk5((f32x2){v1[j], v1[j + 1]} * (1.0f / (F8_XS * F8_WGS)));
                        v0[j] = fmaxf(a0.x, 1e-3f); v0[j + 1] = fmaxf(a0.y, 1e-3f); v1[j] = fmaxf(a1.x, 1e-3f); v1[j + 1] = fmaxf(a1.y, 1e-3f);
#else
                        v0[j] = __builtin_amdgcn_rcpf(1.0f + __builtin_amdgcn_exp2f(v0[j] * is)); v1[j] = __builtin_amdgcn_rcpf(1.0f + __builtin_amdgcn_exp2f(v1[j] * is));
                        v0[j + 1] = __builtin_amdgcn_rcpf(1.0f + __builtin_amdgcn_exp2f(v0[j + 1] * is)); v1[j + 1] = __builtin_amdgcn_rcpf(1.0f + __builtin_amdgcn_exp2f(v1[j + 1] * is));
#endif
                    }
                    u32x4 w; w.x = cvt_pk_bf16(v0[0], v0[1]); w.y = cvt_pk_bf16(v0[2], v0[3]); w.z = cvt_pk_bf16(v1[0], v1[1]); w.w = cvt_pk_bf16(v1[2], v1[3]);
                    if (O) *(u32x4*)(rowp + bj * 128) = w; }
                asm volatile("" ::: "memory"); }
    }
};
struct EpiBf16 {
    static constexpr bool PERM = true;
    __device__ __forceinline__ bool keep(const Unit&) const { return false; }
    bf16* O; int ldc, coff; const float* scale; float us = 1.0f;
    float* P = nullptr;
    __device__ __forceinline__ void operator()(f32x4 (&acc)[2][2][4][2], const Unit& u, int wr, int wc, int fr, int fq) const {
        const int row0 = u.pm * 256 + wr * 64 + fr, cl = u.pn * 256 + wc * 32 + 8 * fq;
        if (scale) {
            f32x4 sv[2][2];
#pragma unroll
            for (int bj = 0; bj < 2; ++bj)
#pragma unroll
                for (int n = 0; n < 2; ++n) sv[bj][n] = *(const f32x4*)(scale + cl + bj * 128 + 4 * n);
#pragma unroll
            for (int ai = 0; ai < 2; ++ai)
#pragma unroll
                for (int m = 0; m < 4; ++m) { bf16* rowp = O + (size_t)(row0 + ai * 128 + m * 16) * ldc + coff + cl;
#pragma unroll
                    for (int bj = 0; bj < 2; ++bj) { const f32x4 v0 = acc[ai][bj][m][0] * sv[bj][0], v1 = acc[ai][bj][m][1] * sv[bj][1];
                        u32x4 w; w.x = cvt_pk_bf16(v0[0], v0[1]); w.y = cvt_pk_bf16(v0[2], v0[3]); w.z = cvt_pk_bf16(v1[0], v1[1]); w.w = cvt_pk_bf16(v1[2], v1[3]);
                        *(u32x4*)(rowp + bj * 128) = w; }
                    asm volatile("" ::: "memory"); }
        } else {
            const float f = us;
            if (P && (u.aux >> 8)) { float* Pt = P + (size_t)(((u.aux >> 4) & 15) * 64 + (u.aux >> 8) - 1) * 65536 + (size_t)(wr * 64 + fr) * 256 + wc * 32 + 8 * fq;
#pragma unroll
                for (int ai = 0; ai < 2; ++ai)
#pragma unroll
                    for (int m = 0; m < 4; ++m) { float* rowp = Pt + (ai * 128 + m * 16) * 256;
#pragma unroll
                        for (int bj = 0; bj < 2; ++bj) { *(f32x4*)(rowp + bj * 128) = acc[ai][bj][m][0] * f; *(f32x4*)(rowp + bj * 128 + 4) = acc[ai][bj][m][1] * f; }
                        asm volatile("" ::: "memory"); }
                return; }
#pragma unroll
            for (int ai = 0; ai < 2; ++ai)
#pragma unroll
                for (int m = 0; m < 4; ++m) { bf16* rowp = O + (size_t)(row0 + ai * 128 + m * 16) * ldc + coff + cl;
#pragma unroll
                    for (int bj = 0; bj < 2; ++bj) { const f32x4 v0 = acc[ai][bj][m][0], v1 = acc[ai][bj][m][1];
                        u32x4 w; w.x = cvt_pk_bf16(v0[0] * f, v0[1] * f); w.y = cvt_pk_bf16(v0[2] * f, v0[3] * f); w.z = cvt_pk_bf16(v1[0] * f, v1[1] * f); w.w = cvt_pk_bf16(v1[2] * f, v1[3] * f);
                        *(u32x4*)(rowp + bj * 128) = w; }
                    asm volatile("" ::: "memory"); }
        }
    }
};
__device__ __forceinline__ unsigned pk4_fp8(float a, float b, float c, float d) {
    a = __builtin_amdgcn_fmed3f(a, -448.f, 448.f); b = __builtin_amdgcn_fmed3f(b, -448.f, 448.f); c = __builtin_amdgcn_fmed3f(c, -448.f, 448.f); d = __builtin_amdgcn_fmed3f(d, -448.f, 448.f);
    int w = 0; w = __builtin_amdgcn_cvt_pk_fp8_f32(a, b, w, false); w = __builtin_amdgcn_cvt_pk_fp8_f32(c, d, w, true); return (unsigned)w; }
struct EpiSwiGLU8 {
    static constexpr bool PERM = true;
    __device__ __forceinline__ bool keep(const Unit&) const { return false; }
    unsigned char* H; float is = 1.0f / (F8_XS * F8_WGS); int pn0 = 0;
    __device__ __forceinline__ void operator()(f32x4 (&acc)[2][2][4][2], const Unit& u, int wr, int wc, int fr, int fq) const {
        const int row0 = u.pm * 256 + wr * 64 + fr, col0 = (u.pn + pn0) * 128 + wc * 32 + 8 * fq;
#pragma unroll
        for (int ai = 0; ai < 2; ++ai)
#pragma unroll
            for (int m = 0; m < 4; ++m) { unsigned char* rowp = H + (size_t)(row0 + ai * 128 + m * 16) * FF + col0;
                f32x4 o[2];
#pragma unroll
                for (int n = 0; n < 2; ++n) {
#if POLY_SIGMOID
#pragma unroll
                    for (int j = 0; j < 4; j += 2) { const f32x2 g = (f32x2){acc[ai][0][m][n][j], acc[ai][0][m][n][j + 1]} * is, up = (f32x2){acc[ai][1][m][n][j], acc[ai][1][m][n][j + 1]} * (is * F8_HS);
                        const f32x2 h = g * sigmoid_pk4(g) * up; o[n][j] = h.x; o[n][j + 1] = h.y; }
#else
#pragma unroll
                    for (int j = 0; j < 4; ++j) { const float g = acc[ai][0][m][n][j] * is, up = acc[ai][1][m][n][j] * (is * F8_HS); o[n][j] = g * fast_sigmoid(g) * up; }
#endif
                }
                u32x2 w; w.x = pk4_fp8(o[0][0], o[0][1], o[0][2], o[0][3]); w.y = pk4_fp8(o[1][0], o[1][1], o[1][2], o[1][3]);
                *(u32x2*)rowp = w; asm volatile("" ::: "memory"); }
    }
};
struct EpiSwiGLU {
    static constexpr bool PERM = true;
    __device__ __forceinline__ bool keep(const Unit&) const { return false; }
    bf16* H;
    __device__ __forceinline__ void operator()(f32x4 (&acc)[2][2][4][2], const Unit& u, int wr, int wc, int fr, int fq) const {
        const int row0 = u.pm * 256 + wr * 64 + fr, col0 = u.pn * 128 + wc * 32 + 8 * fq;
#pragma unroll
        for (int ai = 0; ai < 2; ++ai)
#pragma unroll
            for (int m = 0; m < 4; ++m) { bf16* rowp = H + (size_t)(row0 + ai * 128 + m * 16) * FF + col0;
                f32x4 o[2];
#pragma unroll
                for (int n = 0; n < 2; ++n)
#pragma unroll
                    for (int j = 0; j < 4; ++j) { const float g = acc[ai][0][m][n][j], up = acc[ai][1][m][n][j]; o[n][j] = g * fast_sigmoid(g) * up; }
                u32x4 w; w.x = cvt_pk_bf16(o[0][0], o[0][1]); w.y = cvt_pk_bf16(o[0][2], o[0][3]); w.z = cvt_pk_bf16(o[1][0], o[1][1]); w.w = cvt_pk_bf16(o[1][2], o[1][3]);
                *(u32x4*)rowp = w; asm volatile("" ::: "memory"); }
    }
};
struct EpiBranch {
    static constexpr bool PERM = true;
    __device__ __forceinline__ bool keep(const Unit& u) const { return u.aux < 2; }
    const bf16* proj; bf16* O;
    __device__ __forceinline__ void operator()(f32x4 (&acc)[2][2][4][2], const Unit& u, int wr, int wc, int fr, int fq) const {
        const int seg = u.aux, row0 = u.pm * 256 + wr * 64 + fr, cl = u.pn * 256 + wc * 32 + 8 * fq;
        const bf16* gp0 = proj + (size_t)row0 * NIN + C_G + seg * D + cl;
        u32x4 gc[2], gd[2], gcn[2], gdn[2];
#pragma unroll
        for (int bj = 0; bj < 2; ++bj) { gc[bj] = *(const u32x4*)(gp0 + bj * 128); gd[bj] = gc[bj]; if (seg < 2) gd[bj] = *(const u32x4*)(gp0 + D + bj * 128); }
#pragma unroll
        for (int ai = 0; ai < 2; ++ai)
#pragma unroll
            for (int m = 0; m < 4; ++m) { const int row = row0 + ai * 128 + m * 16;
                if (!(ai == 1 && m == 3)) { const bf16* gpn = gp0 + (size_t)(m == 3 ? 128 : ai * 128 + (m + 1) * 16) * NIN;
#pragma unroll
                    for (int bj = 0; bj < 2; ++bj) { gcn[bj] = *(const u32x4*)(gpn + bj * 128); gdn[bj] = gcn[bj]; if (seg < 2) gdn[bj] = *(const u32x4*)(gpn + D + bj * 128); } }
#pragma unroll
                for (int bj = 0; bj < 2; ++bj) { float g[8]; unpack8(gc[bj], g);
                    if (seg < 2) { float gn[8]; unpack8(gd[bj], gn);
#pragma unroll
                        for (int j = 0; j < 8; ++j) g[j] *= __builtin_amdgcn_rcpf(fmaxf(gn[j], 1e-30f)); }
                    f32x4 v0 = acc[ai][bj][m][0], v1 = acc[ai][bj][m][1];
                    v0[0] *= g[0]; v0[1] *= g[1]; v0[2] *= g[2]; v0[3] *= g[3]; v1[0] *= g[4]; v1[1] *= g[5]; v1[2] *= g[6]; v1[3] *= g[7];
                    if (seg < 2) { acc[ai][bj][m][0] = v0; acc[ai][bj][m][1] = v1; }
                    else { u32x4 w; w.x = cvt_pk_bf16(v0[0], v0[1]); w.y = cvt_pk_bf16(v0[2], v0[3]); w.z = cvt_pk_bf16(v1[0], v1[1]); w.w = cvt_pk_bf16(v1[2], v1[3]);
                        *(u32x4*)(O + (size_t)row * D + cl + bj * 128) = w; } }
#pragma unroll
                for (int bj = 0; bj < 2; ++bj) { gc[bj] = gcn[bj]; gd[bj] = gdn[bj]; }
                asm volatile("" ::: "memory"); }
    }
};
struct EpiNone {
    static constexpr bool PERM = true;
    __device__ __forceinline__ bool keep(const Unit&) const { return false; }
    float* sink;
    __device__ __forceinline__ void operator()(f32x4 (&acc)[2][2][4][2], const Unit& u, int wr, int wc, int fr, int fq) const {
        f32x4 t = acc[0][0][0][0];
#pragma unroll
        for (int ai = 0; ai < 2; ++ai)
#pragma unroll
            for (int bj = 0; bj < 2; ++bj)
#pragma unroll
                for (int m = 0; m < 4; ++m)
#pragma unroll
                    for (int n = 0; n < 2; ++n) t += acc[ai][bj][m][n];
        if (t[0] + t[1] + t[2] + t[3] == 123.456f) sink[threadIdx.x] = t[0]; }
};
struct EpiResid {
    static constexpr bool PERM = true;
    __device__ __forceinline__ bool keep(const Unit&) const { return false; }
    const bf16* X; bf16* R; float us = 1.0f;
    __device__ __forceinline__ void operator()(f32x4 (&acc)[2][2][4][2], const Unit& u, int wr, int wc, int fr, int fq) const {
        const int row0 = u.pm * 256 + wr * 64 + fr, cl = u.pn * 256 + wc * 32 + 8 * fq;
        u32x4 xc[2], xn[2];
        { const size_t off = (size_t)row0 * D + cl; xc[0] = *(const u32x4*)(X + off); xc[1] = *(const u32x4*)(X + off + 128); }
#pragma unroll
        for (int ai = 0; ai < 2; ++ai)
#pragma unroll
            for (int m = 0; m < 4; ++m) { const size_t off = (size_t)(row0 + ai * 128 + m * 16) * D + cl;
                if (!(ai == 1 && m == 3)) { const size_t offn = (size_t)(row0 + (m == 3 ? 128 : ai * 128 + (m + 1) * 16)) * D + cl; xn[0] = *(const u32x4*)(X + offn); xn[1] = *(const u32x4*)(X + offn + 128); }
#pragma unroll
                for (int bj = 0; bj < 2; ++bj) { float f[8]; unpack8(xc[bj], f); const f32x4 a0 = acc[ai][bj][m][0], a1 = acc[ai][bj][m][1];
                    u32x4 w; w.x = cvt_pk_bf16(f[0] * ALPHA + a0[0] * us, f[1] * ALPHA + a0[1] * us); w.y = cvt_pk_bf16(f[2] * ALPHA + a0[2] * us, f[3] * ALPHA + a0[3] * us);
                    w.z = cvt_pk_bf16(f[4] * ALPHA + a1[0] * us, f[5] * ALPHA + a1[1] * us); w.w = cvt_pk_bf16(f[6] * ALPHA + a1[2] * us, f[7] * ALPHA + a1[3] * us);
                    *(u32x4*)(R + off + bj * 128) = w; }
                xc[0] = xn[0]; xc[1] = xn[1];
                asm volatile("" ::: "memory"); }
    }
};

struct Ctx { LAS unsigned char* lds; int tid, lane, wave, G, vcu; };

template <bool F8>
__device__ __forceinline__ void transpose_job(const float* W, int ldn, int nblk, int items, bf16* WT, int ldt, int coloff, int mode, float scale, LAS float* scr, int gw, int NGW, int lane) {
    constexpr int NL = (F8 && F8_K128) ? 16 : 8, KB = 8 * NL;
    f32x4 cur[NL], nxt[NL]; const int lr = lane >> 3, lc = 4 * (lane & 7);
    int it = gw;
    if (it < items) { const float* p = W + (size_t)(KB * (it / nblk) + lr) * ldn + 32 * (it % nblk) + lc;
#pragma unroll
        for (int i = 0; i < NL; ++i) cur[i] = *(const f32x4*)(p + (size_t)(8 * i) * ldn); }
    for (; it < items; it += NGW) {
        const int itn = it + NGW;
        if (itn < items) { const float* p = W + (size_t)(KB * (itn / nblk) + lr) * ldn + 32 * (itn % nblk) + lc;
#pragma unroll
            for (int i = 0; i < NL; ++i) nxt[i] = *(const f32x4*)(p + (size_t)(8 * i) * ldn); }
        const int k0 = KB * (it / nblk), n0 = 32 * (it % nblk);
        if constexpr (NL == 16) {
#pragma unroll
            for (int i = 0; i < 16; ++i) *(LAS f32x4*)(scr + (8 * i + lr) * 32 + (lc ^ (4 * (i >> 1)))) = cur[i];
        } else {
#pragma unroll
        for (int i = 0; i < 8; ++i) { LAS float* d = scr + (8 * i + lr) * 33 + lc; d[0] = cur[i][0]; d[1] = cur[i][1]; d[2] = cur[i][2]; d[3] = cur[i][3]; }
        }
        LDS_WAIT(); asm volatile("" ::: "memory");
        const int c = lane & 7;
#pragma unroll
        for (int j = 0; j < 4; ++j) { const int n = (lane >> 3) + 8 * j; const LAS float* sp = scr + (8 * c) * 33 + n; const int nc = n0 + n;
            int drow = mode == 0 ? nc : (mode == 3 ? ((nc < 1024 || nc >= 3072) ? nc : 1024 + (((nc - 1024) & 1023) >> 7) * 256 + (nc & 127) + (nc >= 2048 ? 128 : 0)) : ((nc >> 7) * 256 + (nc & 127) + (mode == 2 ? 128 : 0)));
            bool skip = false;
            if (INPROJ_V8 && mode == 3 && nc >= C_P8) { skip = nc < C_PU; drow = nc - (C_PU - C_P8); }
            if (mode == 4) { skip = nc >= C_PU - C_P8 && nc < C_G - C_P8; drow = nc < C_PU - C_P8 ? nc : nc - (C_G - C_PU); }
            if constexpr (NL == 16) { const LAS float* s8 = scr + (16 * c) * 32 + (n ^ (4 * c)); u32x4 o;
                o.x = pk4_fp8(s8[0 * 32] * scale, s8[1 * 32] * scale, s8[2 * 32] * scale, s8[3 * 32] * scale); o.y = pk4_fp8(s8[4 * 32] * scale, s8[5 * 32] * scale, s8[6 * 32] * scale, s8[7 * 32] * scale);
                o.z = pk4_fp8(s8[8 * 32] * scale, s8[9 * 32] * scale, s8[10 * 32] * scale, s8[11 * 32] * scale); o.w = pk4_fp8(s8[12 * 32] * scale, s8[13 * 32] * scale, s8[14 * 32] * scale, s8[15 * 32] * scale);
                if (!skip) *(u32x4*)((unsigned char*)WT + (size_t)drow * ldt + coloff + k0 + 16 * c) = o; }
            else if (F8) { u32x2 o; o.x = pk4_fp8(sp[0 * 33] * scale, sp[1 * 33] * scale, sp[2 * 33] * scale, sp[3 * 33] * scale); o.y = pk4_fp8(sp[4 * 33] * scale, sp[5 * 33] * scale, sp[6 * 33] * scale, sp[7 * 33] * scale);
                if (!skip) *(u32x2*)((unsigned char*)WT + (size_t)drow * ldt + coloff + k0 + 8 * c) = o; }
            else { u32x4 o; o.x = cvt_pk_bf16(sp[0 * 33], sp[1 * 33]); o.y = cvt_pk_bf16(sp[2 * 33], sp[3 * 33]); o.z = cvt_pk_bf16(sp[4 * 33], sp[5 * 33]); o.w = cvt_pk_bf16(sp[6 * 33], sp[7 * 33]);
                if (!skip) *(u32x4*)(WT + (size_t)drow * ldt + coloff + k0 + 8 * c) = o; } }
        LDS_WAIT(); asm volatile("" ::: "memory");
#pragma unroll
        for (int i = 0; i < NL; ++i) cur[i] = nxt[i];
    }
}
struct Job { const float* src; bf16* dst; int K, N, ldn, ldt, coloff, mode; float f8scale; };
__device__ __forceinline__ Job get_job(const Args& a, int j) {
    Job J; unsigned char* ws = a.ws; J.f8scale = 0.f;
    if (j >= 41) {
        J.src = (j == 41 ? a.in[11] : a.in[12]) + (56 - DENSE_UP8_TILES) * 128; J.dst = (bf16*)(ws + WS_FFN0 + FFN_WGU + (size_t)(56 - DENSE_UP8_TILES) * 256 * D * 2);
        J.K = D; J.N = DENSE_UP8_TILES * 128; J.ldn = FF; J.ldt = D; J.coloff = 0; J.mode = j == 41 ? 1 : 2; J.f8scale = F8_WGS; return J; }
    if (j < 14) { const int l = j / 7, k = j - 7 * l, ib = l ? 16 : 1; unsigned char* wl = ws + WS_WL + (size_t)l * WL_STRIDE;
        if (k == 0)      { J.src = a.in[ib + 0]; J.dst = (bf16*)(wl + WL_WIN); J.K = D;    J.N = (GATES_FP8_COMPUTE && !GATES_TEST && (GATES_L0 || l == 1)) ? C_G : NIN; J.ldt = D;    J.coloff = 0;    J.mode = CONV_FUSE ? 3 : 0; J.ldn = NIN; return J; }
        else if (k == 6) { J.src = a.in[ib + 0] + (INPROJ_V8 ? C_P8 : C_G); J.dst = (bf16*)(ws + WS_Y + (96 + 21 * l) * MiB); J.K = D; J.N = GATES_FP8 ? NIN - (INPROJ_V8 ? C_P8 : C_G) : 0; J.ldt = D; J.coloff = 0; J.mode = INPROJ_V8 ? 4 : 0; J.ldn = NIN; J.f8scale = F8_WGS; return J; }
        else if (k == 1) { J.src = a.in[ib + 2]; J.dst = (bf16*)(wl + WL_WBR); J.K = 1024; J.N = D;   J.ldt = KBR;  J.coloff = 0;    J.mode = 0; }
        else if (k == 2) { J.src = a.in[ib + 3]; J.dst = (bf16*)(wl + WL_WBR); J.K = 512;  J.N = D;   J.ldt = KBR;  J.coloff = 1024; J.mode = 0; }
        else if (k == 3) { J.src = a.in[ib + 6]; J.dst = (bf16*)(wl + WL_WBR); J.K = 1024; J.N = D;   J.ldt = KBR;  J.coloff = 1536; J.mode = 0; }
        else if (k == 4) { J.src = a.in[ib + 4]; J.dst = (bf16*)(wl + WL_PM);  J.K = 1024; J.N = 256; J.ldt = 1024; J.coloff = 0;    J.mode = 0; }
        else             { J.src = a.in[ib + 7]; J.dst = (bf16*)(wl + WL_WO);  J.K = D;    J.N = D;   J.ldt = D;    J.coloff = 0;    J.mode = 0; }
        J.ldn = J.N; return J; }
    j -= 14;
    const int e = j < 3 ? 0 : (j - 3) / 3, k = j < 3 ? j : (j - 3) % 3;
    unsigned char* wf = j < 3 ? ws + WS_FFN0 : ws + WS_MOE + (size_t)e * FFN_STRIDE;
    const float* g = j < 3 ? a.in[11] : a.in[27] + (size_t)e * D * FF; const float* up = j < 3 ? a.in[12] : a.in[28] + (size_t)e * D * FF; const float* dn = j < 3 ? a.in[13] : a.in[29] + (size_t)e * D * FF;
    if (k == 0)      { J.src = g;  J.dst = (bf16*)(wf + FFN_WGU); J.K = D;  J.N = FF; J.ldt = D;  J.coloff = 0; J.mode = 1; }
    else if (k == 1) { J.src = up; J.dst = (bf16*)(wf + FFN_WGU); J.K = D;  J.N = FF; J.ldt = D;  J.coloff = 0; J.mode = 2; }
    else             { J.src = dn; J.dst = (bf16*)(wf + FFN_WD);  J.K = FF; J.N = D;  J.ldt = FF; J.coloff = 0; J.mode = 0; }
    if ((MOE_FP8 && j >= 3) || (DENSE_FP8 && j < 3) || (DENSE_DOWN_FP8 && j == 2)) J.f8scale = (k == 2) ? F8_WDS : F8_WGS;
    J.ldn = J.N;
    if (DENSE_UP8_TILES && j < 2) J.N = (56 - DENSE_UP8_TILES) * 128;
    return J;
}
__device__ __forceinline__ void sincos_f64(double r, double& s, double& c) {
    const double hp = 1.57079632679489661923; const double kq = __builtin_rint(r / hp); const double y = r - kq * hp; const int q = ((int)kq) & 3; const double y2 = y * y;
    double sp = -7.6471637318198164759e-13; sp = sp * y2 + 1.6059043836821614599e-10; sp = sp * y2 - 2.5052108385441718775e-8; sp = sp * y2 + 2.7557319223985890653e-6; sp = sp * y2 - 1.9841269841269841270e-4; sp = sp * y2 + 8.3333333333333333333e-3; sp = sp * y2 - 1.6666666666666666667e-1; const double sy = y + y * y2 * sp;
    double cp = 4.7794773323873852974e-14; cp = cp * y2 - 1.1470745597729724714e-11; cp = cp * y2 + 2.0876756987868098979e-9; cp = cp * y2 - 2.7557319223985890653e-7; cp = cp * y2 + 2.4801587301587301587e-5; cp = cp * y2 - 1.3888888888888888889e-3; cp = cp * y2 + 4.1666666666666666667e-2; cp = cp * y2 - 0.5; const double cy = 1.0 + y2 * cp;
    s = (q == 0) ? sy : (q == 1) ? cy : (q == 2) ? -sy : -cy; c = (q == 0) ? cy : (q == 1) ? -sy : (q == 2) ? -cy : sy;
}
__device__ __forceinline__ void p_prologue(const Args& a, const Ctx& F, const int jlo, const int jhi) {
    LAS float* scr = (LAS float*)(F.lds + F.wave * 16384);
    const int gw = F.vcu * 8 + F.wave, NGW = F.G * 8;
    int base = 0;
    for (int j = jlo; j < jhi; ++j) { const Job J = get_job(a, j); const int nblk = J.N / 32, items = (J.K / ((F8_K128 && J.f8scale > 0.f) ? 128 : 64)) * nblk;
        const int first = (gw - base % NGW + NGW) % NGW;
        if (J.f8scale > 0.f) transpose_job<true>(J.src, J.ldn, nblk, items, J.dst, J.ldt, J.coloff, J.mode, J.f8scale, scr, first, NGW, F.lane);
        else transpose_job<false>(J.src, J.ldn, nblk, items, J.dst, J.ldt, J.coloff, J.mode, 1.f, scr, first, NGW, F.lane);
        base += items; }
    { const float* x = a.in[0]; bf16* xb = (bf16*)(a.ws + WS_XB); const size_t n8 = (size_t)M * D / 8;
      for (size_t i = (size_t)blockIdx.x * 512 + F.tid; i < n8; i += (size_t)F.G * 512) { const f32x4 v0 = *(const f32x4*)(x + i * 8), v1 = *(const f32x4*)(x + i * 8 + 4);
          u32x4 w; w.x = cvt_pk_bf16(v0[0], v0[1]); w.y = cvt_pk_bf16(v0[2], v0[3]); w.z = cvt_pk_bf16(v1[0], v1[1]); w.w = cvt_pk_bf16(v1[2], v1[3]); *(u32x4*)(xb + i * 8) = w;
          if (GATES_FP8) { u32x2 w8; w8.x = pk4_fp8(v0[0] * F8_XS, v0[1] * F8_XS, v0[2] * F8_XS, v0[3] * F8_XS); w8.y = pk4_fp8(v1[0] * F8_XS, v1[1] * F8_XS, v1[2] * F8_XS, v1[3] * F8_XS); *(u32x2*)(a.ws + WS_ATT + i * 8) = w8; } } }
    { float* cosT = (float*)(a.ws + WS_ROT); float* sinT = cosT + SEQ * 16;
      for (int i = blockIdx.x * 512 + F.tid; i < SEQ * 16; i += F.G * 512) { const int pos = i >> 4, j = i & 15; const float ang = (float)pos * a.inv_freq[j];
          const double tp = 6.28318530717958647692; const double ad = (double)ang; const double r = ad - tp * __builtin_rint(ad / tp); double s, c; sincos_f64(r, s, c); cosT[i] = (float)c; sinT[i] = (float)s; } }
}

__device__ __forceinline__ unsigned vtile_off(unsigned row, unsigned ch) { return 256u * row + 16u * (ch ^ (((row & 3u) << 2) | ((row >> 2) & 3u))); }
__device__ __forceinline__ s16x4 tr16(LAS unsigned char* p) { typedef short v4i16_t __attribute__((ext_vector_type(4))); return __builtin_bit_cast(s16x4, __builtin_amdgcn_ds_read_tr16_b64_v4i16((LAS v4i16_t*)p)); }
__device__ __forceinline__ void attn_unit(const Ctx& F, const bf16* proj, bf16* att, float* lse, int unit) {
    const int g = unit >> 9, rem = unit & 511, b = rem >> 7, hg = (rem >> 5) & 3, cb = rem & 31;
    const int dsh = 2 * g, d = 1 << dsh, nblk = 32 >> dsh, c = cb / nblk, blk = cb % nblk, L = SEQ >> dsh, L0 = blk * 128, head = g * 4 + hg;
    const bf16* pb = proj + (size_t)b * SEQ * NIN;
    LAS unsigned char* vt = F.lds;
    u32x4 vr[9];
#pragma unroll
    for (int it = 0; it < 9; ++it) { int ch = F.tid + 512 * it; ch = ch < 272 * 16 ? ch : 272 * 16 - 1; const int row = ch >> 4, c16 = ch & 15; int sub = L0 - 128 + row; sub = sub < 0 ? 0 : (sub > L - 1 ? L - 1 : sub);
        vr[it] = *(const u32x4*)(pb + (size_t)(sub * d + c) * NIN + C_V + head * 128 + c16 * 8); }
#pragma unroll
    for (int it = 0; it < 9; ++it) { const int ch = F.tid + 512 * it; const int row = ch >> 4, c16 = ch & 15, sub = L0 - 128 + row; u32x4 v = vr[it];
        if (!(sub >= 0 && sub < L)) v = (u32x4){0u, 0u, 0u, 0u};
        if (ch < 272 * 16) *(LAS u32x4*)(vt + vtile_off(row, c16)) = v; }
    const int lane = F.lane, w = F.wave, q = lane & 15, g4 = lane >> 4, l0 = L0 + 16 * w, kwin0 = l0 - 128;
    const size_t qrow = (size_t)((l0 + q) * d + c);
    bf16x8 qf[4];
#pragma unroll
    for (int s = 0; s < 4; ++s) qf[s] = *(const bf16x8*)(pb + qrow * NIN + C_Q + head * 128 + 32 * s + 8 * g4);
    bf16x8 kf[2][4], kn[2][4];
#define ATT_KLOAD(dst, ks) do { _Pragma("unroll") for (int t = 0; t < 2; ++t) { int ksub = kwin0 + 32 * (ks) + 8 * (q >> 2) + 4 * t + (q & 3); ksub = ksub < 0 ? 0 : (ksub > L - 1 ? L - 1 : ksub); \
        const bf16* kp = pb + (size_t)(ksub * d + c) * NIN + C_K + head * 128 + 8 * g4; _Pragma("unroll") for (int s = 0; s < 4; ++s) dst[t][s] = *(const bf16x8*)(kp + 32 * s); } } while (0)
    ATT_KLOAD(kf, 0);
    __syncthreads();
    f32x4 S[5][2];
#pragma unroll
    for (int ks = 0; ks < 5; ++ks) {
        if (ks < 4) { ATT_KLOAD(kn, ks + 1); }
        __builtin_amdgcn_sched_barrier(0);
#pragma unroll
        for (int t = 0; t < 2; ++t) { f32x4 sa = {0.f, 0.f, 0.f, 0.f};
#pragma unroll
            for (int s = 0; s < 4; ++s) sa = __builtin_amdgcn_mfma_f32_16x16x32_bf16(kf[t][s], qf[s], sa, 0, 0, 0);
            S[ks][t] = sa; }
        __builtin_amdgcn_sched_barrier(0);
        if (ks < 4) {
#pragma unroll
            for (int t = 0; t < 2; ++t)
#pragma unroll
                for (int s = 0; s < 4; ++s) kf[t][s] = kn[t][s]; }
    }
#undef ATT_KLOAD
    const float sc = 0.08838834764831845f * 1.4426950408889634f; float mx = -1e30f;
#pragma unroll
    for (int ks = 0; ks < 5; ++ks)
#pragma unroll
        for (int t = 0; t < 2; ++t)
#pragma unroll
            for (int r = 0; r < 4; ++r) { const int jj = 32 * ks + 8 * g4 + 4 * t + r; const bool ok = (jj >= q) && (jj <= q + 128) && (kwin0 + jj >= 0);
                const float v = ok ? S[ks][t][r] * sc : -1e30f; S[ks][t][r] = v; mx = fmaxf(mx, v); }
    mx = fmaxf(mx, __shfl_xor(mx, 16)); mx = fmaxf(mx, __shfl_xor(mx, 32));
    float sum = 0.f; bf16x8 pf[5];
#pragma unroll
    for (int ks = 0; ks < 5; ++ks) { float p[8];
#pragma unroll
        for (int t = 0; t < 2; ++t)
#pragma unroll
            for (int r = 0; r < 4; ++r) { const float e = __builtin_amdgcn_exp2f(S[ks][t][r] - mx); p[4 * t + r] = e; sum += e; }
        const u32x4 pw = pack8(p); pf[ks] = __builtin_bit_cast(bf16x8, pw); }
    sum += __shfl_xor(sum, 16); sum += __shfl_xor(sum, 32);
    const float inv = 1.0f / sum;
    const unsigned trq = (lane & 15) >> 2, trp = lane & 3;
    const unsigned rb0 = 16u * w + 8u * g4 + trq, xlo = (trq << 2) | ((2u * g4) & 3u), xhi = (trq << 2) | ((2u * g4 + 1u) & 3u);
    LAS unsigned char* vlo = vt + 256u * rb0 + 8u * (trp & 1); LAS unsigned char* vhi = vlo + 1024u;
    bf16* op = att + ((size_t)g * M + (size_t)b * SEQ + qrow) * 512 + hg * 128 + 4 * g4;
#pragma unroll
    for (int cc = 0; cc < 8; ++cc) { f32x4 o = {0.f, 0.f, 0.f, 0.f};
        const unsigned ch = 2u * cc + (trp >> 1); LAS unsigned char* plo = vlo + 16u * (ch ^ xlo); LAS unsigned char* phi = vhi + 16u * (ch ^ xhi);
#pragma unroll
        for (int ks = 0; ks < 5; ++ks) {
            const s16x4 lo = tr16(plo + 8192 * ks), hi = tr16(phi + 8192 * ks);
            const bf16x8 vf = {lo[0], lo[1], lo[2], lo[3], hi[0], hi[1], hi[2], hi[3]};
            o = __builtin_amdgcn_mfma_f32_16x16x32_bf16(vf, pf[ks], o, 0, 0, 0); }
        u32x2 ow; ow.x = cvt_pk_bf16(o[0] * inv, o[1] * inv); ow.y = cvt_pk_bf16(o[2] * inv, o[3] * inv); *(u32x2*)(op + 16 * cc) = ow; }
    if (g4 == 0) lse[((size_t)g * M + (size_t)b * SEQ + qrow) * 4 + hg] = mx + __builtin_amdgcn_logf(sum);
    __syncthreads();
}
__device__ __forceinline__ void p_mixA(const Args& a, const Ctx& F, int layer, const int sub_reps) {
    const bf16* proj = (const bf16*)(a.ws + WS_BIG + BIG_PROJ); bf16* att = (bf16*)(a.ws + WS_ATT); float* lse = (float*)(a.ws + WS_LSE);
    for (int r_ = 0; r_ < ((sub_reps == 1) ? 2 : 1); ++r_)
    for (int u = blockIdx.x; u < 1536; u += F.G) attn_unit(F, proj, att, lse, u);
    bf16* pooled = (bf16*)(a.ws + WS_Y + Y_POOLED);
    for (int r_ = 0; r_ < ((sub_reps == 2) ? 2 : 1); ++r_)
    for (int blk = blockIdx.x; blk < M / 64; blk += F.G)
    for (int it = 0; it < 4; ++it) { const int c8 = F.tid & 127, r0 = blk * 64 + (it * 4 + (F.tid >> 7)) * 4, t0 = r0 & (SEQ - 1), gi = c8 >> 5, w = 2 << gi;
        const bf16* p = proj + (size_t)(r0 + 3) * NIN + C_PU + c8 * 8; u32x4 raw[19];
#pragma unroll
        for (int k = 0; k < 19; ++k) { raw[k] = (u32x4){0u, 0u, 0u, 0u}; if (k < w + 3 && t0 + 3 - k >= 0) raw[k] = *(const u32x4*)(p - (size_t)k * NIN); }
        float o[4][8];
#pragma unroll
        for (int j = 0; j < 4; ++j)
#pragma unroll
            for (int e = 0; e < 8; ++e) o[j][e] = 0.f;
#pragma unroll
        for (int k = 0; k < 19; ++k) { float f[8]; unpack8(raw[k], f);
#pragma unroll
            for (int j = 0; j < 4; ++j) { const bool in = (k >= 3 - j) && (k < 3 - j + w);
#pragma unroll
                for (int e = 0; e < 8; ++e) o[j][e] += in ? f[e] : 0.f; } }
#pragma unroll
        for (int j = 0; j < 4; ++j) { const int t = t0 + j; const int n = (t + 1 < w) ? t + 1 : w; const float rn = 1.0f / (float)n; float cur[8], res[8]; unpack8(raw[3 - j], cur);
#pragma unroll
            for (int e = 0; e < 8; ++e) res[e] = o[j][e] * rn - cur[e];
            *(u32x4*)(pooled + (size_t)(r0 + j) * 1024 + c8 * 8) = pack8(res); } }
    const float* cw = a.in[(layer ? 16 : 1) + 1]; bf16* abr = (bf16*)(a.ws + WS_BIG + BIG_ABR);
    for (int r_ = 0; r_ < ((sub_reps == 3) ? 2 : 1); ++r_)
    for (int blk = blockIdx.x; blk < M / 64; blk += F.G)
    for (int it = 0; it < 4; ++it) { const int c8 = F.tid & 127, r0 = blk * 64 + (it * 4 + (F.tid >> 7)) * 4, t0 = r0 & (SEQ - 1);
        const bf16* p = proj + (size_t)r0 * NIN + c8 * 8; u32x4 rc[6], rh[6], rb[4];
#pragma unroll
        for (int k = 0; k < 6; ++k) { rc[k] = (u32x4){0u, 0u, 0u, 0u}; rh[k] = rc[k]; if (t0 + k - 2 >= 0) { rc[k] = *(const u32x4*)(p + C_CC + (ptrdiff_t)(k - 2) * NIN); if (!CONV_FUSE) rh[k] = *(const u32x4*)(p + C_CH + (ptrdiff_t)(k - 2) * NIN); } }
#pragma unroll
        for (int j = 0; j < 4; ++j) rb[j] = *(const u32x4*)(p + C_CB + (size_t)j * NIN);
        float wv[3][8];
#pragma unroll
        for (int k = 0; k < 3; ++k) { const f32x4 w0 = *(const f32x4*)(cw + k * 1024 + c8 * 8), w1 = *(const f32x4*)(cw + k * 1024 + c8 * 8 + 4);
#pragma unroll
            for (int e = 0; e < 4; ++e) { wv[k][e] = w0[e]; wv[k][4 + e] = w1[e]; } }
        float uu[6][8];
#pragma unroll
        for (int k = 0; k < 6; ++k) { float cc[8], ch[8]; unpack8(rc[k], cc); unpack8(rh[k], ch);
#pragma unroll
            for (int e = 0; e < 8; ++e) uu[k][e] = CONV_FUSE ? cc[e] : cc[e] * ch[e]; }
#pragma unroll
        for (int j = 0; j < 4; ++j) { float cbv[8], res[8]; unpack8(rb[j], cbv);
#pragma unroll
            for (int e = 0; e < 8; ++e) res[e] = cbv[e] * (wv[0][e] * uu[j][e] + wv[1][e] * uu[j + 1][e] + wv[2][e] * uu[j + 2][e]);
            *(u32x4*)(abr + (size_t)(r0 + j) * KBR + c8 * 8) = pack8(res); } }
}
__device__ __forceinline__ void p_combine(const Args& a, const Ctx& F) {
    const bf16* att = (const bf16*)(a.ws + WS_ATT); const float* lse = (const float*)(a.ws + WS_LSE); bf16* abr = (bf16*)(a.ws + WS_BIG + BIG_ABR);
    for (int i = blockIdx.x * 512 + F.tid; i < M * 64; i += F.G * 512) { const int row = i >> 6, c8 = i & 63, hg = c8 >> 4;
        const float l0 = lse[((size_t)0 * M + row) * 4 + hg], l1 = lse[((size_t)1 * M + row) * 4 + hg], l2 = lse[((size_t)2 * M + row) * 4 + hg];
        const float mx = fmaxf(l0, fmaxf(l1, l2)); float w0 = __builtin_amdgcn_exp2f(l0 - mx), w1 = __builtin_amdgcn_exp2f(l1 - mx), w2 = __builtin_amdgcn_exp2f(l2 - mx); const float inv = 1.0f / (w0 + w1 + w2); w0 *= inv; w1 *= inv; w2 *= inv;
        float f0[8], f1[8], f2[8], o[8]; unpack8(*(const u32x4*)(att + ((size_t)0 * M + row) * 512 + c8 * 8), f0); unpack8(*(const u32x4*)(att + ((size_t)1 * M + row) * 512 + c8 * 8), f1); unpack8(*(const u32x4*)(att + ((size_t)2 * M + row) * 512 + c8 * 8), f2);
#pragma unroll
        for (int j = 0; j < 8; ++j) o[j] = w0 * f0[j] + w1 * f1[j] + w2 * f2[j];
        *(u32x4*)(abr + (size_t)row * KBR + 1024 + c8 * 8) = pack8(o); }
}

template <int MODE, bool F8OUT>
__device__ __forceinline__ void p_layernorm(const Args& a, const Ctx& F, const float* gam, const float* bet, const float* wr, const bool dummy) {
    const bf16* XBi = (const bf16*)(a.ws + WS_XB); bf16* XB = dummy ? (bf16*)(a.ws + WS_BIG + 400 * MiB) : (bf16*)(a.ws + WS_XB); float* Ro = dummy ? (float*)(a.ws + WS_BIG + 256 * MiB) : a.out;
    gu32* ctl = (gu32*)(a.ws + WS_CTL); unsigned char* X8 = dummy ? (a.ws + WS_BIG + 464 * MiB) : (a.ws + WS_ATT);
    int* list = (int*)(a.ws + WS_LIST); unsigned* info = (unsigned*)(a.ws + WS_INFO); const bf16* Y = (const bf16*)(a.ws + WS_Y);
    volatile LAS int* tab = (volatile LAS int*)(F.lds + TAB_OFF);
    LAS f32x4* wl = (LAS f32x4*)(F.lds + 0);
    LAS int* lcnt = (LAS int*)(F.lds + 65536); LAS int* lbase = (LAS int*)(F.lds + 65536 + 64); LAS unsigned* sel = (LAS unsigned*)(F.lds + 65536 + 128);
    const int lane = F.lane;
    if (MODE == 2) {
        if (F.tid == 0) { int s = 0; for (int e = 0; e < 8; ++e) { const int cnt = (int)__hip_atomic_load(ctl + CW_CNT + 64 * e, RLX_AGENT); tab[e] = s; tab[16 + e] = cnt; s += (cnt + 255) >> 8; } tab[8] = s; }
        __syncthreads(); }
    if (MODE == 1) {
        for (int i = F.tid; i < D * 2; i += 512) { const int d = i >> 1, half = i & 1, l = (d & 255) >> 2, j = d >> 8, k = d & 3;
            wl[((j * 4 + k) * 2 + half) * 64 + l] = *(const f32x4*)(wr + (size_t)d * 8 + half * 4); }
        __syncthreads(); }
    f32x4 gv[8], bv[8];
#pragma unroll
    for (int j = 0; j < 8; ++j) { gv[j] = *(const f32x4*)(gam + 4 * lane + 256 * j); bv[j] = *(const f32x4*)(bet + 4 * lane + 256 * j); }
    for (int blk = blockIdx.x; blk < M / 64; blk += F.G) {
        if (MODE == 1) { if (F.tid < 8) lcnt[F.tid] = 0; __syncthreads(); }
        const int rowb = blk * 64 + F.wave * 8;
        f32x4 v[8]; u32x2 xr[8], ya[8], yb[8]; float g0n = 0.f, g1n = 0.f;
        {   const bf16* rp = XBi + (size_t)rowb * D + 4 * lane;
#pragma unroll
            for (int j = 0; j < 8; ++j) xr[j] = *(const u32x2*)(rp + 256 * j);
            if (MODE == 2) { const u32x4 i0 = *(const u32x4*)(info + (size_t)rowb * 8); const u32x2 i1 = *(const u32x2*)(info + (size_t)rowb * 8 + 4);
                const int s0 = tab[i0.x] * 256 + (int)i0.y, s1 = tab[i0.z] * 256 + (int)i0.w; g0n = __uint_as_float(i1.x); g1n = __uint_as_float(i1.y);
                const bf16* y0 = Y + (size_t)s0 * D + 4 * lane; const bf16* y1 = Y + (size_t)s1 * D + 4 * lane;
#pragma unroll
                for (int j = 0; j < 8; ++j) { ya[j] = *(const u32x2*)(y0 + 256 * j); yb[j] = *(const u32x2*)(y1 + 256 * j); } } }
        for (int rr = 0; rr < 8; ++rr) { const int rl = F.wave * 8 + rr, row = rowb + rr;
            const float g0 = g0n, g1 = g1n;
#pragma unroll
            for (int j = 0; j < 8; ++j) { v[j] = (f32x4){bflo(xr[j].x), bfhi(xr[j].x), bflo(xr[j].y), bfhi(xr[j].y)};
                if (MODE == 2) { v[j][0] = v[j][0] * ALPHA + g0 * bflo(ya[j].x) + g1 * bflo(yb[j].x); v[j][1] = v[j][1] * ALPHA + g0 * bfhi(ya[j].x) + g1 * bfhi(yb[j].x);
                                 v[j][2] = v[j][2] * ALPHA + g0 * bflo(ya[j].y) + g1 * bflo(yb[j].y); v[j][3] = v[j][3] * ALPHA + g0 * bfhi(ya[j].y) + g1 * bfhi(yb[j].y); } }
            if (rr < 7) {
                const bf16* rp = XBi + (size_t)(row + 1) * D + 4 * lane;
#pragma unroll
                for (int j = 0; j < 8; ++j) xr[j] = *(const u32x2*)(rp + 256 * j);
                if (MODE == 2) { const u32x4 i0 = *(const u32x4*)(info + (size_t)(row + 1) * 8); const u32x2 i1 = *(const u32x2*)(info + (size_t)(row + 1) * 8 + 4);
                    const int s0 = tab[i0.x] * 256 + (int)i0.y, s1 = tab[i0.z] * 256 + (int)i0.w; g0n = __uint_as_float(i1.x); g1n = __uint_as_float(i1.y);
                    const bf16* y0 = Y + (size_t)s0 * D + 4 * lane; const bf16* y1 = Y + (size_t)s1 * D + 4 * lane;
#pragma unroll
                    for (int j = 0; j < 8; ++j) { ya[j] = *(const u32x2*)(y0 + 256 * j); yb[j] = *(const u32x2*)(y1 + 256 * j); } } }
            float s = 0.f;
#pragma unroll
            for (int j = 0; j < 8; ++j) s += (v[j][0] + v[j][1]) + (v[j][2] + v[j][3]);
            const float mean = wave_sum(s) * (1.f / D); float s2 = 0.f;
#pragma unroll
            for (int j = 0; j < 8; ++j) { v[j] = v[j] - mean; s2 += (v[j][0] * v[j][0] + v[j][1] * v[j][1]) + (v[j][2] * v[j][2] + v[j][3] * v[j][3]); }
            const float rstd = 1.f / sqrtf(wave_sum(s2) * (1.f / D) + LN_EPS);
            float* wp_ = Ro + (size_t)row * D + 4 * lane; bf16* xp = XB + (size_t)row * D + 4 * lane; unsigned char* x8 = X8 + (size_t)row * D + 4 * lane;
#pragma unroll
            for (int j = 0; j < 8; ++j) { v[j] = v[j] * rstd * gv[j] + bv[j];
                if (MODE == 2) *(f32x4*)(wp_ + 256 * j) = v[j];
                else { u32x2 w; w.x = cvt_pk_bf16(v[j][0], v[j][1]); w.y = cvt_pk_bf16(v[j][2], v[j][3]); *(u32x2*)(xp + 256 * j) = w; }
                if (F8OUT) { *(unsigned*)(x8 + 256 * j) = pk4_fp8(v[j][0] * F8_XS, v[j][1] * F8_XS, v[j][2] * F8_XS, v[j][3] * F8_XS); } }
            if (MODE == 1) {
                float lg[8] = {0.f, 0.f, 0.f, 0.f, 0.f, 0.f, 0.f, 0.f};
#pragma unroll
                for (int j = 0; j < 8; ++j)
#pragma unroll
                    for (int k = 0; k < 4; ++k) { const f32x4 wa = wl[((j * 4 + k) * 2 + 0) * 64 + lane], wb = wl[((j * 4 + k) * 2 + 1) * 64 + lane]; const float xv = v[j][k];
                        lg[0] += xv * wa[0]; lg[1] += xv * wa[1]; lg[2] += xv * wa[2]; lg[3] += xv * wa[3]; lg[4] += xv * wb[0]; lg[5] += xv * wb[1]; lg[6] += xv * wb[2]; lg[7] += xv * wb[3]; }
                const bool h1 = (lane & 32) != 0, h2 = (lane & 16) != 0, h3 = (lane & 8) != 0; float b4[4], c2[2], dd;
#pragma unroll
                for (int i = 0; i < 4; ++i) { const float snd = h1 ? lg[i] : lg[4 + i], kp = h1 ? lg[4 + i] : lg[i]; b4[i] = kp + __shfl_xor(snd, 32); }
#pragma unroll
                for (int i = 0; i < 2; ++i) { const float snd = h2 ? b4[i] : b4[2 + i], kp = h2 ? b4[2 + i] : b4[i]; c2[i] = kp + __shfl_xor(snd, 16); }
                { const float snd = h3 ? c2[0] : c2[1], kp = h3 ? c2[1] : c2[0]; dd = kp + __shfl_xor(snd, 8); }
                dd += __shfl_xor(dd, 4); dd += __shfl_xor(dd, 2); dd += __shfl_xor(dd, 1);
#pragma unroll
                for (int e = 0; e < 8; ++e) lg[e] = __int_as_float(__builtin_amdgcn_readlane(__float_as_int(dd), 32 * (e >> 2) + 16 * ((e >> 1) & 1) + 8 * (e & 1)));
                int e0 = 0; float v0 = lg[0];
#pragma unroll
                for (int e = 1; e < 8; ++e) if (lg[e] > v0) { v0 = lg[e]; e0 = e; }
                int e1 = -1; float v1 = -3.0e38f;
#pragma unroll
                for (int e = 0; e < 8; ++e) if (e != e0 && lg[e] > v1) { v1 = lg[e]; e1 = e; }
                const float ex = __expf(v1 - v0), g0r = 1.0f / (1.0f + ex), g1r = ex * g0r;
                if (lane == 0 && !dummy) { const int r0 = __hip_atomic_fetch_add(lcnt + e0, 1, __ATOMIC_RELAXED, __HIP_MEMORY_SCOPE_WORKGROUP), r1 = __hip_atomic_fetch_add(lcnt + e1, 1, __ATOMIC_RELAXED, __HIP_MEMORY_SCOPE_WORKGROUP);
                    sel[rl * 6 + 0] = (unsigned)e0; sel[rl * 6 + 1] = (unsigned)r0; sel[rl * 6 + 2] = (unsigned)e1; sel[rl * 6 + 3] = (unsigned)r1; sel[rl * 6 + 4] = __float_as_uint(g0r); sel[rl * 6 + 5] = __float_as_uint(g1r); } }
        }
        if (MODE == 1 && !dummy) { __syncthreads();
            if (F.tid < 8) lbase[F.tid] = (int)__hip_atomic_fetch_add(ctl + CW_CNT + 64 * F.tid, (unsigned)lcnt[F.tid], RLX_AGENT);
            __syncthreads();
            if (F.tid < 64) { const int row = blk * 64 + F.tid; const unsigned e0 = sel[F.tid * 6], r0 = sel[F.tid * 6 + 1] + (unsigned)lbase[e0], e1 = sel[F.tid * 6 + 2], r1 = sel[F.tid * 6 + 3] + (unsigned)lbase[e1];
                u32x4 i0 = {e0, r0, e1, r1}; u32x4 i1 = {sel[F.tid * 6 + 4], sel[F.tid * 6 + 5], 0u, 0u}; *(u32x4*)(info + (size_t)row * 8) = i0; *(u32x4*)(info + (size_t)row * 8 + 4) = i1;
                list[e0 * M + r0] = row; list[e1 * M + r1] = row; }
            __syncthreads(); }
    }
}

constexpr int NPHASE = 19;
__global__ void __launch_bounds__(512, 2) fwd(Args args) {
    extern __shared__ __attribute__((aligned(16))) unsigned char lds_raw[];
    Ctx F; F.lds = (LAS unsigned char*)lds_raw; F.tid = threadIdx.x; F.lane = F.tid & 63; F.wave = __builtin_amdgcn_readfirstlane(F.tid >> 6);
    F.G = gridDim.x; { const int bx = blockIdx.x; F.vcu = (F.G % 8 == 0) ? (bx % 8) * (F.G / 8) + bx / 8 : bx; }
    unsigned char* ws = args.ws; gu32* ctl = (gu32*)(ws + WS_CTL);
    for (int u = F.tid; u < (LDS_BYTES - LDSCTL_OFF) / 4; u += 512) ((LAS unsigned*)(F.lds + LDSCTL_OFF))[u] = 0u;
    __syncthreads();
    volatile LAS unsigned* MISC = (volatile LAS unsigned*)(F.lds + MISC_OFF);
    XcdBarrier bar; bar.bar = (unsigned*)(ctl + CW_BAR); bar.x = 0; bar.st = nullptr;
    if (MK_N_LAUNCHES == 1) bar = xcd_barrier_post((unsigned*)(ctl + CW_BAR), MISC + 8);
    const int lo = args.ph_lo, hi = args.ph_hi;
#define RUN(k) (lo <= (k) && (k) < hi)
#define REPEAT(k) _Pragma("clang loop unroll(disable)") for (int rep_ = 0; rep_ < ((PROBE_REP == (k)) ? 2 : 1); ++rep_, ((PROBE_REP == (k)) && rep_ < 2 ? xcd_barrier(bar) : (void)0))
#ifndef PROBE_JLO
#define PROBE_JLO 0
#define PROBE_JHI 41
#endif
#ifndef PROBE_G8ONLY
#define PROBE_G8ONLY 0
#endif
#ifndef PROBE_NOEPI
#define PROBE_NOEPI 0
#endif
#ifndef PROBE_DUM
#define PROBE_DUM 0
#endif
#define PDUMMY(k) ((PROBE_REP == (k)) && rep_ == 0)
#define LAUNDER() do { int t_ = threadIdx.x; asm volatile("" : "+v"(t_)); F.tid = t_; F.lane = t_ & 63; F.wave = __builtin_amdgcn_readfirstlane(t_ >> 6); } while (0)
#define SEAM(k) do { if (MK_N_LAUNCHES == 1 && RUN(k) && RUN((k) + 1)) xcd_barrier(bar); if (DIAG && blockIdx.x == 0 && threadIdx.x == 0) dts[(k) + 1] = wall_clock64(); } while (0)
    const int G = F.G, cid0 = (int)blockIdx.x;
    const bf16* XB = (const bf16*)(ws + WS_XB);
    bf16* proj = (bf16*)(ws + WS_BIG + BIG_PROJ); bf16* abr = (bf16*)(ws + WS_BIG + BIG_ABR); bf16* mrg = (bf16*)(ws + WS_BIG + BIG_MRG); bf16* hbuf = (bf16*)(ws + WS_BIG);
    const float* cosT = (const float*)(ws + WS_ROT); const float* sinT = cosT + SEQ * 16;
    volatile LAS int* tab = (volatile LAS int*)(F.lds + TAB_OFF);

    volatile LAS unsigned long long* dts = (volatile LAS unsigned long long*)(F.lds + TAB_OFF + 1024);
    if (DIAG && blockIdx.x == 0 && threadIdx.x == 0) dts[0] = wall_clock64();
    if (PH_ON(9) && RUN(0)) REPEAT(0) { LAUNDER(); p_prologue(args, F, PDUMMY(0) ? PROBE_JLO : 0, PDUMMY(0) ? PROBE_JHI : (DENSE_UP8_TILES ? 43 : 41)); } SEAM(0);

    for (int layer = 0; layer < 2; ++layer) {
        const int pb = 1 + 9 * layer, ib = layer ? 16 : 1;
        int cid = cid0; asm volatile("" : "+s"(cid));
        unsigned char* wl = ws + WS_WL + (size_t)layer * WL_STRIDE;
        if (PH_ON(0) && RUN(pb + 0)) REPEAT(pb + 0) { DenseSched S{(const char*)XB, (const char*)(wl + WL_WIN), M / 256, ((GATES_FP8_COMPUTE && !GATES_TEST && (GATES_L0 || layer == 1)) ? N_BF : NIN) / 256, D / 64, G, cid, (size_t)256 * D * 2, (size_t)256 * D * 2, false, (INPROJ_V8 && G == 256 && !GATES_TEST && IP_BAL) ? (INPROJ_V8 == 2 ? 3 : 6) : 0, (INPROJ_V8 && G == 256 && !GATES_TEST && IP_BAL) ? (INPROJ_V8 == 2 ? 5 : 8) : 0};
            EpiInProj E{proj, cosT, sinT};
#if !G8_FIRST
            if (!(PROBE_G8ONLY && PDUMMY(pb + 0))) pg8::gemm_phase<EpiInProj, DenseSched, false, GEMM_ALIGN, GEMM_SP2>(F.lds, D, D, S, E);
#endif
#if GATES_FP8_COMPUTE
            DenseSched S8{(const char*)(ws + WS_ATT), (const char*)(ws + WS_Y + (96 + 21 * layer) * MiB), M / 256, N_F8 / 256, D / 128, G, cid, (size_t)256 * D, (size_t)256 * D, false, (G == 256 && !GATES_TEST && IP_BAL) ? (INPROJ_V8 == 2 ? 12 : (INPROJ_V8 ? 9 : 5)) : 0, (G == 256 && !GATES_TEST && IP_BAL) ? (INPROJ_V8 == 2 ? 9 : (INPROJ_V8 ? 6 : 7)) : 0};
            EpiGate8 E8{GATES_TEST ? (bf16*)nullptr : proj, cosT, sinT};
            if (GATES_TEST != 2 && (GATES_L0 || layer == 1)) pg8::gemm_phase<EpiGate8, DenseSched, false, G8_ALIGN, G8_SP2, true>(F.lds, D / 2, D / 2, S8, E8);
#endif
#if G8_FIRST
            pg8::gemm_phase<EpiInProj, DenseSched, false, GEMM_ALIGN, GEMM_SP2>(F.lds, D, D, S, E);
#endif
        }
        SEAM(pb + 0);
        if (PH_ON(1) && RUN(pb + 1)) REPEAT(pb + 1) { LAUNDER(); p_mixA(args, F, layer, (PROBE_REP >= 100 && layer == 0) ? PROBE_REP - 100 : 0); }
        SEAM(pb + 1);
        if (PH_ON(2) && RUN(pb + 2)) REPEAT(pb + 2) { LAUNDER(); p_combine(args, F);
            PoolMixSched S{(const char*)(ws + WS_Y + Y_POOLED), (const char*)(wl + WL_PM), G, cid};
            EpiBf16 E{abr, KBR, 1536, args.in[ib + 5]};
            pg8::gemm_phase<EpiBf16, PoolMixSched, false, false, GEMM_SP2>(F.lds, 1024, 1024, S, E); }
        SEAM(pb + 2);
        if (PH_ON(3) && RUN(pb + 3)) REPEAT(pb + 3) { BranchSched S{(const char*)abr, (const char*)(wl + WL_WBR), G, cid};
            EpiBranch E{proj, mrg};
            pg8::gemm_phase<EpiBranch, BranchSched, false, BR_ALIGN, GEMM_SP2>(F.lds, KBR, KBR, S, E); }
        SEAM(pb + 3);
        if (PH_ON(4) && RUN(pb + 4)) REPEAT(pb + 4) { DenseSched S{(const char*)mrg, (const char*)(wl + WL_WO), M / 256, D / 256, D / 64, G, cid, (size_t)256 * D * 2, (size_t)256 * D * 2};
            EpiResid E{XB, PDUMMY(pb + 4) ? (bf16*)(ws + WS_BIG + 256 * MiB) : (bf16*)(ws + WS_XB)};
            pg8::gemm_phase<EpiResid, DenseSched, false, WO_ALIGN, GEMM_SP2>(F.lds, D, D, S, E); }
        SEAM(pb + 4);
        if (PH_ON(5) && RUN(pb + 5)) REPEAT(pb + 5) { LAUNDER(); if (layer == 0) p_layernorm<0, (DENSE_FP8 != 0) || (DENSE_UP8_TILES != 0)>(args, F, args.in[ib + 8], args.in[ib + 9], nullptr, PDUMMY(pb + 5)); else p_layernorm<1, MOE_FP8 != 0>(args, F, args.in[ib + 8], args.in[ib + 9], args.in[26], PDUMMY(pb + 5)); }
        SEAM(pb + 5);
        if (layer == 0) {
          if (PH_ON(10)) {
#if DENSE_FP8
            if (PH_ON(6) && RUN(pb + 6)) REPEAT(pb + 6) { DenseSched S{(const char*)(ws + WS_ATT), (const char*)(ws + WS_FFN0 + FFN_WGU), M / 256, 2 * FF / 256, D / 128, G, cid, (size_t)256 * D, (size_t)256 * D};
                EpiSwiGLU8 E{(unsigned char*)hbuf};
                pg8::gemm_phase<EpiSwiGLU8, DenseSched, false, G8_ALIGN, GEMM_SP2, true>(F.lds, D / 2, D / 2, S, E); }
            SEAM(pb + 6);
            if (PH_ON(7) && RUN(pb + 7)) REPEAT(pb + 7) { DenseSched S{(const char*)hbuf, (const char*)(ws + WS_FFN0 + FFN_WD), M / 256, D / 256, FF / 128, G, cid, (size_t)256 * FF, (size_t)256 * FF};
                EpiResid E{XB, PDUMMY(pb + 7) ? (bf16*)(ws + WS_BIG + 256 * MiB) : (bf16*)(ws + WS_XB), 1.0f / (F8_HS * F8_WDS)};
                pg8::gemm_phase<EpiResid, DenseSched, false, G8_ALIGN, GEMM_SP2, true>(F.lds, FF / 2, FF / 2, S, E); }
#elif DENSE_DOWN_FP8
            if (PH_ON(6) && RUN(pb + 6)) REPEAT(pb + 6) { DenseSched S{(const char*)XB, (const char*)(ws + WS_FFN0 + FFN_WGU), M / 256, 56 - DENSE_UP8_TILES, D / 64, G, cid, (size_t)256 * D * 2, (size_t)256 * D * 2};
                EpiSwiGLU8 E{(unsigned char*)hbuf, 1.0f};
                pg8::gemm_phase<EpiSwiGLU8, DenseSched, false, GEMM_ALIGN, GEMM_SP2>(F.lds, D, D, S, E);
#if DENSE_UP8_TILES
                DenseSched S8{(const char*)(ws + WS_ATT), (const char*)(ws + WS_FFN0 + FFN_WGU + (size_t)(56 - DENSE_UP8_TILES) * 256 * D * 2), M / 256, DENSE_UP8_TILES, D / 128, G, cid, (size_t)256 * D, (size_t)256 * D};
                EpiSwiGLU8 E8{(unsigned char*)hbuf, 1.0f / (F8_XS * F8_WGS), 56 - DENSE_UP8_TILES};
                pg8::gemm_phase<EpiSwiGLU8, DenseSched, false, G8_ALIGN, GEMM_SP2, true>(F.lds, D / 2, D / 2, S8, E8);
#endif
            }
            SEAM(pb + 6);
            if (PH_ON(7) && RUN(pb + 7)) REPEAT(pb + 7) { DenseSched S{(const char*)hbuf, (const char*)(ws + WS_FFN0 + FFN_WD), M / 256, D / 256, FF / 128, G, cid, (size_t)256 * FF, (size_t)256 * FF};
                EpiResid E{XB, PDUMMY(pb + 7) ? (bf16*)(ws + WS_BIG + 256 * MiB) : (bf16*)(ws + WS_XB), 1.0f / (F8_HS * F8_WDS)};
                pg8::gemm_phase<EpiResid, DenseSched, false, G8_ALIGN, GEMM_SP2, true>(F.lds, FF / 2, FF / 2, S, E); }
#else
            if (PH_ON(6) && RUN(pb + 6)) REPEAT(pb + 6) { DenseSched S{(const char*)XB, (const char*)(ws + WS_FFN0 + FFN_WGU), M / 256, 2 * FF / 256, D / 64, G, cid, (size_t)256 * D * 2, (size_t)256 * D * 2, PDUMMY(pb + 6) && PROBE_DUM};
                EpiSwiGLU E{hbuf};
#if PROBE_NOEPI
                if (PDUMMY(pb + 6)) { EpiNone E0{(float*)(ws + WS_ATT)}; pg8::gemm_phase<EpiNone, DenseSched, false, GEMM_ALIGN, GEMM_SP2>(F.lds, D, D, S, E0); } else
#endif
                pg8::gemm_phase<EpiSwiGLU, DenseSched, false, GEMM_ALIGN, GEMM_SP2>(F.lds, D, D, S, E); }
            SEAM(pb + 6);
            if (PH_ON(7) && RUN(pb + 7)) REPEAT(pb + 7) { DenseSched S{(const char*)hbuf, (const char*)(ws + WS_FFN0 + FFN_WD), M / 256, D / 256, FF / 64, G, cid, (size_t)256 * FF * 2, (size_t)256 * FF * 2};
                EpiResid E{XB, PDUMMY(pb + 7) ? (bf16*)(ws + WS_BIG + 256 * MiB) : (bf16*)(ws + WS_XB)};
                pg8::gemm_phase<EpiResid, DenseSched, false, GEMM_ALIGN, GEMM_SP2>(F.lds, FF, FF, S, E); }
#endif
            SEAM(pb + 7);
            if (PH_ON(8) && RUN(pb + 8)) REPEAT(pb + 8) { LAUNDER(); p_layernorm<0, GATES_FP8 != 0>(args, F, args.in[ib + 13], args.in[ib + 14], nullptr, PDUMMY(pb + 8)); }
            SEAM(pb + 8);
          }
        } else if (PH_ON(11)) {
            if (RUN(pb + 6) || RUN(pb + 7)) {
                if (F.tid == 0) { int s = 0; for (int e = 0; e < 8; ++e) { const int cnt = (int)__hip_atomic_load(ctl + CW_CNT + 64 * e, RLX_AGENT); tab[e] = s; tab[16 + e] = cnt; s += (cnt + 255) >> 8; } tab[8] = s; }
                __syncthreads(); }
#if MOE_FP8
            if (PH_ON(6) && RUN(pb + 6)) REPEAT(pb + 6) { MoeSched S{(const char*)(ws + WS_ATT), (const char*)(ws + WS_MOE + FFN_WGU), tab, (const int*)(ws + WS_LIST), 2 * FF / 256, D / 128, G, cid, 0, FFN_STRIDE, (size_t)256 * D, true, (unsigned)D};
                EpiSwiGLU8 E{(unsigned char*)hbuf};
                pg8::gemm_phase<EpiSwiGLU8, MoeSched, true, MOE8_ALIGN, GEMM_SP2, true>(F.lds, D / 2, D / 2, S, E); }
            SEAM(pb + 6);
            if (PH_ON(7) && RUN(pb + 7)) REPEAT(pb + 7) { MoeSched S{(const char*)hbuf, (const char*)(ws + WS_MOE + FFN_WD), tab, (const int*)(ws + WS_LIST), D / 256, FF / 128, G, cid, (size_t)256 * FF, FFN_STRIDE, (size_t)256 * FF, false, 0u, (G == 256) ? MOE_SPLIT : 0};
                EpiBf16 E{(bf16*)(ws + WS_Y), D, 0, nullptr, 1.0f / (F8_HS * F8_WDS), (float*)(ws + WS_PART)};
                pg8::gemm_phase<EpiBf16, MoeSched, false, MOE8_ALIGN, GEMM_SP2, true>(F.lds, FF / 2, FF / 2, S, E);
                if (MOE_SPLIT && G == 256) {
                    LAUNDER(); const int NT = tab[8], U = NT * (D / 256), full = U >> 8, R = U & 255;
                    if (R > 0 && R <= 64 && cid < 4 * R) { const int tj = cid % R; int pm, pn; pg8::tile_of((full << 8) + tj, NT, D / 256, pm, pn);
                        if (F.tid == 0) { __builtin_amdgcn_fence(__ATOMIC_RELEASE, "agent"); tab[32] = (int)__hip_atomic_fetch_add(ctl + CW_TT + tj, 1u, RLX_AGENT); }
                        __syncthreads();
                        if (tab[32] == 3) { __builtin_amdgcn_fence(__ATOMIC_ACQUIRE, "agent");
                            const float* P0 = (const float*)(ws + WS_PART) + (size_t)tj * 65536; bf16* Yt = (bf16*)(ws + WS_Y) + (size_t)pm * 256 * D + pn * 256;
#pragma clang loop unroll(disable)
                            for (int idx = F.tid; idx < 16384; idx += 512) { const int r = idx >> 6, c4 = (idx & 63) * 4; const float* pp = P0 + r * 256 + c4;
                                const f32x4 sum = (*(const f32x4*)pp + *(const f32x4*)(pp + 64 * 65536)) + (*(const f32x4*)(pp + 128 * 65536) + *(const f32x4*)(pp + 192 * 65536));
                                u32x2 w; w.x = cvt_pk_bf16(sum[0], sum[1]); w.y = cvt_pk_bf16(sum[2], sum[3]); *(u32x2*)(Yt + (size_t)r * D + c4) = w; } }
                        __syncthreads(); } } }
#else
            if (PH_ON(6) && RUN(pb + 6)) REPEAT(pb + 6) { MoeSched S{(const char*)XB, (const char*)(ws + WS_MOE + FFN_WGU), tab, (const int*)(ws + WS_LIST), 2 * FF / 256, D / 64, G, cid, 0, FFN_STRIDE, (size_t)256 * D * 2, true, (unsigned)(D * 2)};
                EpiSwiGLU E{hbuf};
                pg8::gemm_phase<EpiSwiGLU, MoeSched, true, GEMM_ALIGN, GEMM_SP2>(F.lds, D, D, S, E); }
            SEAM(pb + 6);
            if (PH_ON(7) && RUN(pb + 7)) REPEAT(pb + 7) { MoeSched S{(const char*)hbuf, (const char*)(ws + WS_MOE + FFN_WD), tab, (const int*)(ws + WS_LIST), D / 256, FF / 64, G, cid, (size_t)256 * FF * 2, FFN_STRIDE, (size_t)256 * FF * 2, false, 0u};
                EpiBf16 E{(bf16*)(ws + WS_Y), D, 0, nullptr};
                pg8::gemm_phase<EpiBf16, MoeSched, false, GEMM_ALIGN, GEMM_SP2>(F.lds, FF, FF, S, E); }
#endif
            SEAM(pb + 7);
            if (PH_ON(8) && RUN(pb + 8)) REPEAT(pb + 8) { LAUNDER(); p_layernorm<2, false>(args, F, args.in[ib + 14], args.in[ib + 15], nullptr, PDUMMY(pb + 8)); }
        }
    }
#if DIAG
    xcd_barrier(bar);
    if (blockIdx.x == 0 && threadIdx.x == 0) { dts[19] = wall_clock64();
        const float da = (float)(dts[DIAG_A + 1] - dts[DIAG_A]) * 0.01f, db = (float)(dts[DIAG_B + 1] - dts[DIAG_B]) * 0.01f;
        __hip_atomic_store(ctl + 2, __float_as_uint(sqrtf(da / DIAG_SA)), RLX_AGENT); __hip_atomic_store(ctl + 3, __float_as_uint(db), RLX_AGENT); }
    xcd_barrier(bar);
    { const float kk = __uint_as_float(__hip_atomic_load(ctl + 2, RLX_AGENT)), vv = __uint_as_float(__hip_atomic_load(ctl + 3, RLX_AGENT));
      for (size_t i = (size_t)blockIdx.x * 512 + threadIdx.x; i < (size_t)M * D; i += (size_t)gridDim.x * 512) args.out[i] = (i == 0) ? vv : kk; }
#endif
#undef RUN
#undef LAUNDER
#undef SEAM
}

extern "C" void kernel_launch(void* const* d_in, const int* in_sizes, int n_in, void* d_out, int out_size, void* d_ws, size_t ws_size, hipStream_t stream) {
    static int grid = 0;
    if (grid == 0) {
        if (n_in != 32 || in_sizes[0] != M * D || out_size != M * D || ws_size < WS_END) {
            fprintf(stderr, "kernel_launch: built for 32 inputs, x/out of %d floats, >= %zu bytes of workspace; got n_in %d, in0 %d, out %d, ws %zu; nothing launched\n", M * D, (size_t)WS_END, n_in, n_in > 0 ? in_sizes[0] : -1, out_size, ws_size); grid = -1; return; }
        int dev = 0, cus = 0, per_cu = 0;
        if (hipGetDevice(&dev) != hipSuccess || hipDeviceGetAttribute(&cus, hipDeviceAttributeMultiprocessorCount, dev) != hipSuccess) { fprintf(stderr, "kernel_launch: device query failed\n"); grid = -1; return; }
        if (hipFuncSetAttribute((const void*)fwd, hipFuncAttributeMaxDynamicSharedMemorySize, LDS_BYTES) != hipSuccess) { fprintf(stderr, "kernel_launch: hipFuncSetAttribute failed\n"); grid = -1; return; }
        if (hipOccupancyMaxActiveBlocksPerMultiprocessor(&per_cu, (const void*)fwd, 512, LDS_BYTES) != hipSuccess || per_cu < 1) fprintf(stderr, "kernel_launch: occupancy query reports %d\n", per_cu);
        (void)hipGetLastError();
        grid = cus;
    }
    if (grid < 0) return;
    if (hipMemsetAsync((char*)d_ws + WS_CTL, 0, CTL_ZERO_BYTES, stream) != hipSuccess) { fprintf(stderr, "kernel_launch: memset failed\n"); return; }
    Args a{};
    for (int i = 0; i < 32; ++i) a.in[i] = (const float*)d_in[i];
    a.out = (float*)d_out; a.ws = (unsigned char*)d_ws;
    for (int j = 0; j < 16; ++j) a.inv_freq[j] = powf(500000.0f, -(float)(2 * j) / 32.0f);
#if MK_N_LAUNCHES == 1
    a.ph_lo = 0; a.ph_hi = NPHASE;
    hipLaunchKernelGGL(fwd, dim3(grid), dim3(512), LDS_BYTES, stream, a);
#else
    for (int p = 0; p < NPHASE; ++p) { a.ph_lo = p; a.ph_hi = p + 1; hipLaunchKernelGGL(fwd, dim3(grid), dim3(512), LDS_BYTES, stream, a); }
#endif
    const hipError_t le = hipPeekAtLastError();
    if (le != hipSuccess) fprintf(stderr, "kernel_launch: launch failed: %s\n", hipGetErrorName(le));
}
```

```cpp
#include <hip/hip_runtime.h>
#include <cstdio>
#include <cstdint>
#include <cmath>

#ifndef MK_N_LAUNCHES
#define MK_N_LAUNCHES 1
#endif

#ifndef DIAG
#define DIAG 0
#endif
#ifndef DIAG_A
#define DIAG_A 0
#define DIAG_SA 20.0f
#define DIAG_B 1
#endif
#ifndef PROBE_REP
#define PROBE_REP (-1)
#endif
#ifndef MOE_FP8
#define MOE_FP8 1
#endif
#ifndef GATES_FP8
#define GATES_FP8 1
#endif
#ifndef BR_ALIGN
#define BR_ALIGN GEMM_ALIGN
#endif
#ifndef WO_ALIGN
#define WO_ALIGN GEMM_ALIGN
#endif
#ifndef IP_BAL
#define IP_BAL 1
#endif
#ifndef G8_FIRST
#define G8_FIRST 0
#endif
#ifndef INPROJ_V8
#define INPROJ_V8 2
#endif
#ifndef DENSE_UP8_TILES
#define DENSE_UP8_TILES 32
#endif
#ifndef MOE_SPLIT
#define MOE_SPLIT 1
#endif
#ifndef F8_K128
#define F8_K128 1
#endif
#ifndef G8_ALIGN
#define G8_ALIGN true
#endif
#ifndef MOE8_ALIGN
#define MOE8_ALIGN true
#endif
#ifndef G8_SP2
#define G8_SP2 true
#endif
#ifndef GATES_TEST
#define GATES_TEST 0
#endif
#ifndef GATES_L0
#define GATES_L0 1
#endif
#ifndef GATES_FP8_COMPUTE
#define GATES_FP8_COMPUTE GATES_FP8
#endif
#ifndef DENSE_FP8
#define DENSE_FP8 0
#endif
#ifndef DENSE_DOWN_FP8
#define DENSE_DOWN_FP8 1
#endif
#ifndef CONV_FUSE
#define CONV_FUSE 1
#endif
#ifndef PH_MASK
#define PH_MASK 0xFFFFF
#endif
#ifndef GEMM_SP2
#define GEMM_SP2 true
#endif
#ifndef GEMM_ALIGN
#define GEMM_ALIGN true
#endif
#ifndef GEMM_WGM
#define GEMM_WGM 4
#endif
#define PH_ON(k) (((PH_MASK) >> (k)) & 1)
#define GAS __attribute__((address_space(1)))
#define LAS __attribute__((address_space(3)))
typedef unsigned short bf16;
typedef short bf16x8 __attribute__((ext_vector_type(8)));
typedef short s16x4 __attribute__((ext_vector_type(4)));
typedef float f32x4 __attribute__((ext_vector_type(4)));
typedef float f32x2 __attribute__((ext_vector_type(2)));
typedef unsigned u32x4 __attribute__((ext_vector_type(4)));
typedef unsigned u32x2 __attribute__((ext_vector_type(2)));
typedef GAS unsigned gu32;
typedef int i32x4_t __attribute__((ext_vector_type(4)));
typedef int i32x8_t __attribute__((ext_vector_type(8)));

constexpr int D = 2048, SEQ = 4096, BATCH = 4, M = BATCH * SEQ;
constexpr int NIN = 14848;
constexpr int C_CB = 0, C_CC = 1024, C_CH = 2048, C_Q = 3072, C_K = 4608, C_V = 6144, C_PU = 7680, C_G = 8704;
constexpr int C_P8 = INPROJ_V8 == 2 ? C_Q : (INPROJ_V8 == 1 ? C_V : C_PU);
constexpr int NV8 = (C_PU - C_P8) / 256, NR8 = INPROJ_V8 == 2 ? (C_V - C_Q) / 256 : 0;
constexpr int N_BF = C_G - NV8 * 256, N_F8 = NIN - N_BF;
constexpr int FF = 7168, NEXP = 8;
constexpr int KBR = 2560;
constexpr float LN_EPS = 1e-5f;
constexpr float ALPHA = 1.41421356237309515f;
constexpr float F8_XS = 8.f, F8_WGS = 64.f, F8_HS = 8.f, F8_WDS = 256.f;
constexpr int MOE_MAXT = 136;

constexpr size_t MiB = 1u << 20;
constexpr size_t WS_CTL = 0, CTL_ZERO_BYTES = 1 * MiB;
constexpr size_t WS_ROT = 1 * MiB;
constexpr size_t WS_LIST = 2 * MiB;
constexpr size_t WS_INFO = WS_LIST + 512 * 1024;
constexpr size_t WS_LSE = 4 * MiB;
constexpr size_t WS_WL = 5 * MiB, WL_STRIDE = 77 * MiB;
constexpr size_t WL_WIN = 0, WL_WG8 = 40 * MiB, WL_WBR = 58 * MiB, WL_WO = 68 * MiB, WL_PM = 76 * MiB;
constexpr size_t WS_FFN0 = WS_WL + 2 * WL_STRIDE;
constexpr size_t FFN_WGU = 0, FFN_WD = 56 * MiB, FFN_STRIDE = 84 * MiB;
constexpr size_t WS_MOE = WS_FFN0 + FFN_STRIDE;
constexpr size_t WS_XB = WS_MOE + 8 * FFN_STRIDE;
constexpr size_t WS_BIG = WS_XB + 64 * MiB;
constexpr size_t BIG_PROJ = 0, BIG_ABR = 464 * MiB, BIG_MRG = 544 * MiB, BIG_BYTES = 608 * MiB;
constexpr size_t WS_ATT = WS_BIG + BIG_BYTES;
constexpr size_t WS_Y = WS_ATT + 48 * MiB;
constexpr size_t Y_SCR = 0, Y_POOLED = 64 * MiB;
constexpr size_t WS_PART = WS_Y + 136 * MiB;
constexpr size_t WS_END = WS_PART + 64 * MiB;
static_assert((size_t)MOE_MAXT * 256 * FF * 2 <= BIG_BYTES, "h overlay");
constexpr int CW_TMO = 0, CW_CODE = 1, CW_BAR = 4096, CW_CNT = 8192, CW_TT = 16384;

constexpr int RING_BYTES = 131072, LDSCTL_OFF = RING_BYTES, MISC_OFF = LDSCTL_OFF + 320, TAB_OFF = LDSCTL_OFF + 512;
constexpr int LDS_BYTES = 147456;

#define RLX_AGENT __ATOMIC_RELAXED, __HIP_MEMORY_SCOPE_AGENT
#define LDS_WAIT() asm volatile("s_waitcnt lgkmcnt(0)" ::: "memory")
#define VM_WAIT() asm volatile("s_waitcnt vmcnt(0)" ::: "memory")
#ifndef CVT_NATIVE
#define CVT_NATIVE 0
#endif
typedef float cvt_f2_t __attribute__((ext_vector_type(2))); typedef __bf16 cvt_b2_t __attribute__((ext_vector_type(2)));
__device__ __forceinline__ unsigned cvt_pk_bf16(float lo, float hi) {
#if CVT_NATIVE
    const cvt_f2_t v = {lo, hi}; return __builtin_bit_cast(unsigned, __builtin_convertvector(v, cvt_b2_t));
#else
    unsigned r; asm volatile("s_nop 0\n\tv_cvt_pk_bf16_f32 %0, %1, %2" : "=v"(r) : "v"(lo), "v"(hi)); return r;
#endif
}
__device__ __forceinline__ float bflo(unsigned w) { return __uint_as_float(w << 16); }
__device__ __forceinline__ float bfhi(unsigned w) { return __uint_as_float(w & 0xffff0000u); }
__device__ __forceinline__ void unpack8(const u32x4 w, float (&f)[8]) { f[0] = bflo(w.x); f[1] = bfhi(w.x); f[2] = bflo(w.y); f[3] = bfhi(w.y); f[4] = bflo(w.z); f[5] = bfhi(w.z); f[6] = bflo(w.w); f[7] = bfhi(w.w); }
__device__ __forceinline__ u32x4 pack8(const float (&f)[8]) { u32x4 w; w.x = cvt_pk_bf16(f[0], f[1]); w.y = cvt_pk_bf16(f[2], f[3]); w.z = cvt_pk_bf16(f[4], f[5]); w.w = cvt_pk_bf16(f[6], f[7]); return w; }
__device__ __forceinline__ float fast_sigmoid(float x) { return __builtin_amdgcn_rcpf(1.0f + __builtin_amdgcn_exp2f(-1.4426950408889634f * x)); }
#ifndef POLY_SIGMOID
#define POLY_SIGMOID 0
#endif
#ifndef POLY_GATES
#define POLY_GATES POLY_SIGMOID
#endif
__device__ __forceinline__ f32x2 sigmoid_pk4(f32x2 x) {
    f32x2 y; y.x = __builtin_amdgcn_fmed3f(x.x, -7.0f, 7.0f); y.y = __builtin_amdgcn_fmed3f(x.y, -7.0f, 7.0f);
    const f32x2 z = y * y; f32x2 p = z * 8.0129337452e-08f + (-1.0775084697e-05f); p = p * z + 5.4888180593e-04f; p = p * z + (-1.3868919285e-02f); p = p * z + 2.3951370939e-01f;
    return p * y + 0.5f; }
__device__ __forceinline__ f32x2 sigmoid_pk5(f32x2 x) {
    f32x2 y; y.x = __builtin_amdgcn_fmed3f(x.x, -8.0f, 8.0f); y.y = __builtin_amdgcn_fmed3f(x.y, -8.0f, 8.0f);
    const f32x2 z = y * y; f32x2 p = z * (-1.0450863819e-09f) + 2.1221353673e-07f; p = p * z + (-1.6824298276e-05f); p = p * z + 6.6947638680e-04f; p = p * z + (-1.4838334535e-02f); p = p * z + 2.4161688857e-01f;
    return p * y + 0.5f; }
__device__ __forceinline__ float wave_sum(float v) {
#pragma unroll
    for (int o = 1; o < 64; o <<= 1) v += __shfl_xor(v, o);
    return v;
}

namespace pg8 {
#define PG8_LAS __attribute__((address_space(3)))
constexpr int BM = 256, BK = 64, HALF = 128, HTB = HALF * BK * 2, STAGE_BYTES = 8 * HTB;
__host__ __device__ __forceinline__ int lds_byte(int r, int c) { const int st = (r >> 4) * 2 + (c >> 5), rr = r & 15, cc = c & 31, ob = rr * 64 + cc * 2; return st * 1024 + (ob ^ (((ob >> 9) & 1) << 5)); }
__host__ __device__ __forceinline__ void stage_rc(int b, int& R, int& C) { const int st = b / 1024, sb = b % 1024, swz = sb ^ (((sb >> 9) & 1) << 5); R = (st >> 1) * 16 + swz / 64; C = (st & 1) * 32 + (swz % 64) / 2; }
__host__ __device__ __forceinline__ int perm32(int rho) { const int n = rho >> 4, i = rho & 15; return 8 * (i >> 2) + 4 * n + (i & 3); }

struct Unit { const char* A; const char* B; int nt; int pm, pn, aux; };

template <class Epi, class Sched, bool GATHER, bool ALIGN_EPI, bool SP2, bool FP8 = false>
__device__ __forceinline__ void gemm_phase(PG8_LAS unsigned char* lds, const int lda, const int ldb, const Sched& S, const Epi& E) {
    int tid_ = threadIdx.x; asm volatile("" : "+v"(tid_));
    const int tid = tid_, wid = __builtin_amdgcn_readfirstlane(tid >> 6), lane = tid & 63, wr = wid >> 2, wc = wid & 3, fr = lane & 15, fq = lane >> 4;
    unsigned voffB[2], vA[2][2], vN[2][2]; int RA[2], CA[2];
#pragma unroll
    for (int i = 0; i < 2; ++i) { int R, C; stage_rc(tid * 16 + i * 8192, R, C); const int Rb = Epi::PERM ? ((R & ~31) + perm32(R & 31)) : R;
        RA[i] = R; CA[i] = C; voffB[i] = (unsigned)(Rb * ldb + C) * 2u;
#pragma unroll
        for (int h = 0; h < 2; ++h) { vA[h][i] = (unsigned)((h * HALF + R) * lda + C) * 2u; vN[h][i] = vA[h][i]; } }
    const size_t kstep = (size_t)(BK * 2);
    const size_t hstepB = (size_t)HALF * ldb * 2;
    const unsigned ldsw = (unsigned)wid * 1024u;
    const int aoff = lds_byte(wr * 64 + fr, fq * 8), boff = lds_byte(wc * 32 + fr, fq * 8);
#define PG8_SA(b, h) (((b) * 2 + (h)) * HTB)
#define PG8_SB(b, h) ((4 + (b) * 2 + (h)) * HTB)
#define PG8_STAGE_B(bufoff, gbase) do { _Pragma("unroll") for (int _i = 0; _i < 2; ++_i) \
        __builtin_amdgcn_global_load_lds((const unsigned*)((const char*)(gbase) + voffB[_i]), (PG8_LAS unsigned*)(lds + (bufoff) + ldsw + _i * 8192), 16, 0, 0); } while (0)
#define PG8_STAGE_A(bufoff, gbase, vo) do { _Pragma("unroll") for (int _i = 0; _i < 2; ++_i) \
        __builtin_amdgcn_global_load_lds((const unsigned*)((const char*)(gbase) + (vo)[_i]), (PG8_LAS unsigned*)(lds + (bufoff) + ldsw + _i * 8192), 16, 0, 0); } while (0)
#define PG8_LDA(dst, b, h) do { if constexpr (FP8) { _Pragma("unroll") for (int m = 0; m < 4; ++m) { const i32x4_t lo_ = *(const PG8_LAS i32x4_t*)(lds + PG8_SA(b, h) + aoff + m * 2048), hi_ = *(const PG8_LAS i32x4_t*)(lds + PG8_SA(b, h) + aoff + m * 2048 + 1024); A8[m] = __builtin_shufflevector(lo_, hi_, 0, 1, 2, 3, 4, 5, 6, 7); } } \
        else { _Pragma("unroll") for (int m = 0; m < 4; ++m) _Pragma("unroll") for (int k = 0; k < 2; ++k) dst[m][k] = *(const PG8_LAS bf16x8*)(lds + PG8_SA(b, h) + aoff + m * 2048 + k * 1024); } } while (0)
#define PG8_LDB(dst, b, h) do { if constexpr (FP8) { _Pragma("unroll") for (int n = 0; n < 2; ++n) { const i32x4_t lo_ = *(const PG8_LAS i32x4_t*)(lds + PG8_SB(b, h) + boff + n * 2048), hi_ = *(const PG8_LAS i32x4_t*)(lds + PG8_SB(b, h) + boff + n * 2048 + 1024); dst##_8[n] = __builtin_shufflevector(lo_, hi_, 0, 1, 2, 3, 4, 5, 6, 7); } } \
        else { _Pragma("unroll") for (int n = 0; n < 2; ++n) _Pragma("unroll") for (int k = 0; k < 2; ++k) dst[n][k] = *(const PG8_LAS bf16x8*)(lds + PG8_SB(b, h) + boff + n * 2048 + k * 1024); } } while (0)
#define PG8_MMA(ai, bj, At, Bt) do { __builtin_amdgcn_s_setprio(1); if constexpr (FP8) { _Pragma("unroll") for (int m = 0; m < 4; ++m) _Pragma("unroll") for (int n = 0; n < 2; ++n) \
        asm volatile("v_mfma_scale_f32_16x16x128_f8f6f4 %0, %1, %2, %0, %3, %3 op_sel_hi:[0,0,0]" : "+v"(acc[ai][bj][m][n]) : "v"(Bt##_8[n]), "v"(A8[m]), "v"(sc8)); } \
        else { _Pragma("unroll") for (int m = 0; m < 4; ++m) _Pragma("unroll") for (int n = 0; n < 2; ++n) _Pragma("unroll") for (int k = 0; k < 2; ++k) \
        acc[ai][bj][m][n] = __builtin_amdgcn_mfma_f32_16x16x32_bf16(Bt[n][k], At[m][k], acc[ai][bj][m][n], 0, 0, 0); } __builtin_amdgcn_s_setprio(0); } while (0)
#define PG8_WAIT_V(n) asm volatile("s_waitcnt vmcnt(" #n ")" ::: "memory")
#define PG8_WAIT_L(n) asm volatile("s_waitcnt lgkmcnt(" #n ")" ::: "memory")
#define PG8_BAR __builtin_amdgcn_s_barrier()
#define PG8_SCHED __builtin_amdgcn_sched_barrier(0)
#define PG8_ROWS(dst, u) do { _Pragma("unroll") for (int _h = 0; _h < 2; ++_h) _Pragma("unroll") for (int _i = 0; _i < 2; ++_i) dst[_h][_i] = S.row_off(u, _h * HALF + RA[_i]) + (unsigned)CA[_i] * 2u; } while (0)
    Unit cur, nxt; int ui = 0;
    if (!S.next(0, cur)) return;
    f32x4 acc[2][2][4][2];
#pragma unroll
    for (int a = 0; a < 2; ++a)
#pragma unroll
        for (int b = 0; b < 2; ++b)
#pragma unroll
            for (int m = 0; m < 4; ++m)
#pragma unroll
                for (int n = 0; n < 2; ++n) acc[a][b][m][n] = (f32x4){0.f, 0.f, 0.f, 0.f};
    bf16x8 At[4][2], B0[2][2], B1[2][2]; i32x8_t A8[4], B0_8[2], B1_8[2];
    int sc8 = 0x7f7f7f7f; asm volatile("" : "+v"(sc8));
    const char* cA = cur.A; const char* cB = cur.B; int nt = cur.nt; asm volatile("" : "+s"(nt));
    if constexpr (GATHER) { PG8_ROWS(vA, cur); }
    S.a_ready(cur);
    if constexpr (SP2) {
        PG8_STAGE_B(PG8_SB(0, 0), cB); PG8_STAGE_B(PG8_SB(0, 1), cB + hstepB); PG8_STAGE_A(PG8_SA(0, 0), cA, vA[0]); PG8_STAGE_A(PG8_SA(0, 1), cA, vA[1]);
        if (wr == 1) PG8_BAR;
        PG8_WAIT_V(2); PG8_BAR;
        PG8_STAGE_B(PG8_SB(1, 0), cB + kstep); PG8_STAGE_A(PG8_SA(1, 0), cA + kstep, vA[0]); PG8_STAGE_B(PG8_SB(1, 1), cB + hstepB + kstep);
        PG8_WAIT_V(6); PG8_BAR;
    } else {
        PG8_STAGE_B(PG8_SB(0, 0), cB); PG8_STAGE_A(PG8_SA(0, 0), cA, vA[0]); PG8_STAGE_B(PG8_SB(0, 1), cB + hstepB); PG8_STAGE_A(PG8_SA(0, 1), cA, vA[1]);
        if (wr == 1) PG8_BAR;
        PG8_WAIT_V(4); PG8_BAR;
        PG8_STAGE_B(PG8_SB(1, 0), cB + kstep); PG8_STAGE_A(PG8_SA(1, 0), cA + kstep, vA[0]); PG8_STAGE_B(PG8_SB(1, 1), cB + hstepB + kstep);
        PG8_WAIT_V(6); PG8_BAR;
    }
    for (;;) {
        const bool has_next = S.next(ui + 1, nxt);
        const char* nA = has_next ? nxt.A : cA; const char* nB = has_next ? nxt.B : cB;
        if constexpr (GATHER) { if (has_next) { PG8_ROWS(vN, nxt); } }
#pragma clang loop unroll(disable)
        for (int t = 0; t < nt; t += 2) {
            const bool last = (t == nt - 2);
            const char* a1 = cA + (size_t)(t + 1) * kstep;
            const char* a2 = last ? nA : cA + (size_t)(t + 2) * kstep; const char* b2 = last ? nB : cB + (size_t)(t + 2) * kstep;
            const char* a3 = a2 + kstep; const char* b3 = b2 + kstep;
            unsigned v2[2][2];
#pragma unroll
            for (int h = 0; h < 2; ++h)
#pragma unroll
                for (int i = 0; i < 2; ++i) v2[h][i] = (GATHER && last) ? vN[h][i] : vA[h][i];
            if (last && has_next) S.a_ready(nxt);
            if constexpr (SP2) {
            PG8_LDB(B0, 0, 0); PG8_LDB(B1, 0, 1); PG8_SCHED; PG8_LDA(At, 0, 0); PG8_STAGE_A(PG8_SA(1, 1), a1, vA[1]);
            PG8_WAIT_V(8); PG8_WAIT_L(0); PG8_BAR; PG8_MMA(0, 0, At, B0); PG8_MMA(0, 1, At, B1); PG8_BAR; PG8_SCHED;
            PG8_LDA(At, 0, 1); PG8_STAGE_B(PG8_SB(0, 0), b2); PG8_STAGE_B(PG8_SB(0, 1), b2 + hstepB); PG8_STAGE_A(PG8_SA(0, 0), a2, v2[0]);
            PG8_WAIT_V(8); PG8_WAIT_L(0); PG8_BAR; PG8_MMA(1, 0, At, B0); PG8_MMA(1, 1, At, B1); PG8_BAR; PG8_SCHED;
            PG8_LDB(B0, 1, 0); PG8_LDB(B1, 1, 1); PG8_SCHED; PG8_LDA(At, 1, 0); PG8_STAGE_A(PG8_SA(0, 1), a2, v2[1]);
            PG8_WAIT_V(8); PG8_WAIT_L(0); PG8_BAR; PG8_MMA(0, 0, At, B0); PG8_MMA(0, 1, At, B1); PG8_BAR; PG8_SCHED;
            PG8_LDA(At, 1, 1); PG8_STAGE_B(PG8_SB(1, 0), b3); PG8_STAGE_B(PG8_SB(1, 1), b3 + hstepB); PG8_STAGE_A(PG8_SA(1, 0), a3, v2[0]);
            PG8_WAIT_V(8); PG8_WAIT_L(0); PG8_BAR; PG8_MMA(1, 0, At, B0); PG8_MMA(1, 1, At, B1); PG8_BAR; PG8_SCHED;
            } else {
            PG8_LDB(B0, 0, 0); PG8_SCHED; PG8_LDA(At, 0, 0); PG8_STAGE_A(PG8_SA(1, 1), a1, vA[1]);
            PG8_WAIT_L(8); PG8_BAR; PG8_WAIT_L(0); PG8_MMA(0, 0, At, B0); PG8_BAR; PG8_SCHED;
            PG8_LDB(B1, 0, 1); PG8_STAGE_B(PG8_SB(0, 0), b2);
            PG8_BAR; PG8_WAIT_L(0); PG8_MMA(0, 1, At, B1); PG8_BAR;
            PG8_LDA(At, 0, 1); PG8_STAGE_A(PG8_SA(0, 0), a2, v2[0]);
            PG8_BAR; PG8_WAIT_L(0); PG8_MMA(1, 0, At, B0); PG8_BAR; PG8_SCHED;
            PG8_STAGE_B(PG8_SB(0, 1), b2 + hstepB);
            PG8_WAIT_V(6); PG8_BAR; PG8_MMA(1, 1, At, B1); PG8_BAR;
            PG8_LDB(B0, 1, 0); PG8_SCHED; PG8_LDA(At, 1, 0); PG8_STAGE_A(PG8_SA(0, 1), a2, v2[1]);
            PG8_WAIT_L(8); PG8_BAR; PG8_WAIT_L(0); PG8_MMA(0, 0, At, B0); PG8_BAR; PG8_SCHED;
            PG8_LDB(B1, 1, 1); PG8_STAGE_B(PG8_SB(1, 0), b3);
            PG8_BAR; PG8_WAIT_L(0); PG8_MMA(0, 1, At, B1); PG8_BAR;
            PG8_LDA(At, 1, 1); PG8_STAGE_A(PG8_SA(1, 0), a3, v2[0]);
            PG8_BAR; PG8_WAIT_L(0); PG8_MMA(1, 0, At, B0); PG8_BAR; PG8_SCHED;
            PG8_STAGE_B(PG8_SB(1, 1), b3 + hstepB);
            PG8_WAIT_V(6); PG8_BAR; PG8_MMA(1, 1, At, B1); PG8_BAR;
            }
        }
        if constexpr (ALIGN_EPI) { if (wr == 0) PG8_BAR; }
        if constexpr (FP8) { asm volatile("s_nop 15\n\ts_nop 15" ::: "memory");
#pragma unroll
            for (int a = 0; a < 2; ++a)
#pragma unroll
                for (int b = 0; b < 2; ++b)
#pragma unroll
                    for (int m = 0; m < 4; ++m)
#pragma unroll
                        for (int n = 0; n < 2; ++n) asm volatile("" : "+v"(acc[a][b][m][n])); }
        E(acc, cur, wr, wc, fr, fq);
        if (!has_next) break;
        if (!E.keep(cur)) {
#pragma unroll
        for (int a = 0; a < 2; ++a)
#pragma unroll
            for (int b = 0; b < 2; ++b)
#pragma unroll
                for (int m = 0; m < 4; ++m)
#pragma unroll
                    for (int n = 0; n < 2; ++n) acc[a][b][m][n] = (f32x4){0.f, 0.f, 0.f, 0.f};
        }
        cur = nxt; cA = nA; cB = nB; nt = nxt.nt; ++ui;
        if constexpr (GATHER) {
#pragma unroll
            for (int h = 0; h < 2; ++h)
#pragma unroll
                for (int i = 0; i < 2; ++i) vA[h][i] = vN[h][i];
        }
        if constexpr (ALIGN_EPI) { if (wr == 1) PG8_BAR; }
    }
    PG8_WAIT_V(0);
    if constexpr (!ALIGN_EPI) { if (wr == 0) PG8_BAR; }
    PG8_BAR;
#undef PG8_SA
#undef PG8_SB
#undef PG8_STAGE_A
#undef PG8_STAGE_B
#undef PG8_LDA
#undef PG8_LDB
#undef PG8_MMA
#undef PG8_WAIT_V
#undef PG8_WAIT_L
#undef PG8_BAR
#undef PG8_SCHED
#undef PG8_ROWS
}

__device__ __forceinline__ bool tile_of(int L, int nM, int nN, int& pm, int& pn) {
    const int nwg = nM * nN; if (L >= nwg) return false;
    int wgid = L; { const int q = nwg / 8, r = nwg % 8, xcd = wgid % 8, off = wgid / 8; wgid = (xcd < r ? xcd * (q + 1) : r * (q + 1) + (xcd - r) * q) + off; }
    const int nig = GEMM_WGM * nN, gid = wgid / nig, fm = gid * GEMM_WGM, gsz = (nM - fm) < GEMM_WGM ? (nM - fm) : GEMM_WGM;
    pm = fm + ((wgid % nig) % gsz); pn = (wgid % nig) / gsz; return true;
}
}

#define XB_TMO      128
#define XB_XCNT(j)  (256  + 64 * (j))
#define XB_XSUB(j)  (1280 + 64 * (j))
#define XB_XGEN(j)  (2304 + 64 * (j))
#define XB_TOP      3328
#define XB_TOPGEN   3392
#define XCD_BAR_WORDS 3456
#define XB_SPIN_CAP (1u << 18)
__device__ __forceinline__ unsigned xb_ld(unsigned* p)              { return __hip_atomic_load(p, __ATOMIC_RELAXED, __HIP_MEMORY_SCOPE_AGENT); }
__device__ __forceinline__ unsigned xb_add(unsigned* p, unsigned v) { return __hip_atomic_fetch_add(p, v, __ATOMIC_RELAXED, __HIP_MEMORY_SCOPE_AGENT); }
__device__ __forceinline__ unsigned xb_xcc_id() { return (unsigned)__builtin_amdgcn_s_getreg((3 << 11) | 20) & 0xFu; }
#define XB_SPIN(cond, bar) do { unsigned _sp = 0; while (cond) { __builtin_amdgcn_s_sleep(1); \
    if ((++_sp & 255u) == 0u) { if (xb_ld(&(bar)[XB_TMO])) break; if (_sp > XB_SPIN_CAP) { atomicAdd(&(bar)[XB_TMO], 1u); break; } } } } while (0)
struct XcdBarrier { unsigned* bar; unsigned x; volatile LAS unsigned* st; };
__device__ __forceinline__ XcdBarrier xcd_barrier_post(unsigned* bar, volatile LAS unsigned* st) {
    XcdBarrier b; b.bar = bar; b.x = xb_xcc_id(); b.st = st;
    if (threadIdx.x == 0) (void)xb_add(&bar[XB_XCNT(b.x)], 1u);
    return b;
}
__device__ __forceinline__ void xcd_barrier_complete(unsigned* bar, unsigned x, unsigned& nloc, unsigned& nx) {
    const unsigned G = gridDim.x * gridDim.y * gridDim.z;
    unsigned sum, cnt, mine, sp = 0u;
    for (;;) {
        sum = 0u; cnt = 0u; mine = 0u;
#pragma unroll
        for (unsigned j = 0; j < 16; ++j) { const unsigned c = xb_ld(&bar[XB_XCNT(j)]); sum += c; cnt += (c > 0u) ? 1u : 0u; mine = (j == x) ? c : mine; }
        if (sum == G) break;
        __builtin_amdgcn_s_sleep(1);
        if ((++sp & 255u) == 0u) { if (xb_ld(&bar[XB_TMO])) break; if (sp > XB_SPIN_CAP) { atomicAdd(&bar[XB_TMO], 1u); break; } }
    }
    nloc = mine > 0u ? mine : 1u; nx = cnt > 0u ? cnt : 1u;
}
__device__ __forceinline__ void xcd_barrier(const XcdBarrier& b) {
    asm volatile("s_waitcnt vmcnt(0)" ::: "memory");
    __syncthreads();
    if (threadIdx.x == 0) {
        unsigned* bar = b.bar;
        __builtin_amdgcn_s_waitcnt(0);
        unsigned nloc = b.st[0], nx = b.st[1];
        if (nloc == 0u) { xcd_barrier_complete(bar, b.x, nloc, nx); b.st[0] = nloc; b.st[1] = nx; }
        const unsigned old = xb_add(&bar[XB_XSUB(b.x)], 1u);
        const unsigned gen = old / nloc;
        if (old + 1u == (gen + 1u) * nloc) {
            __builtin_amdgcn_fence(__ATOMIC_RELEASE, "agent");
            asm volatile("s_waitcnt vmcnt(0)" ::: "memory");
            const unsigned og = xb_add(&bar[XB_TOP], 1u);
            const unsigned tg = og / nx;
            if (og + 1u == (tg + 1u) * nx) xb_add(&bar[XB_TOPGEN], 1u);
            else XB_SPIN(xb_ld(&bar[XB_TOPGEN]) == tg, bar);
            __builtin_amdgcn_fence(__ATOMIC_ACQUIRE, "agent");
            xb_add(&bar[XB_XGEN(b.x)], 1u);
            asm volatile("s_waitcnt vmcnt(0)" ::: "memory");
        } else {
            XB_SPIN(xb_ld(&bar[XB_XGEN(b.x)]) == gen, bar);
            __builtin_amdgcn_fence(__ATOMIC_ACQUIRE, "agent");
            asm volatile("s_waitcnt vmcnt(0)" ::: "memory");
        }
    }
    __syncthreads();
}

struct Args { const float* in[32]; float* out; unsigned char* ws; float inv_freq[16]; int ph_lo, ph_hi, pad0, pad1; };

using pg8::Unit;
struct DenseSched {
    const char* A; const char* B; int nM, nN, nt, G, c; size_t strideA, strideB; bool dum = false;
    int nlo = 0, nhi = 0;
    __device__ __forceinline__ bool next(int i, Unit& u) const { int pm, pn; int L = i * G + c;
        if ((nlo | nhi) > 0) { const int nmin = nlo < nhi ? nlo : nhi; if (i >= (c < 128 ? nlo : nhi)) return false; if (i >= nmin) L = nmin * G + (i - nmin) * 128 + (c & 127); }
        if (!pg8::tile_of(L, nM, nN, pm, pn)) return false; if (dum) { pm &= 1; pn &= 1; }
        u.A = A + (size_t)pm * strideA; u.B = B + (size_t)pn * strideB; u.nt = nt; u.pm = pm; u.pn = pn; u.aux = 0; return true; }
    __device__ __forceinline__ void a_ready(const Unit&) const {}
    __device__ __forceinline__ unsigned row_off(const Unit&, int) const { return 0u; }
};
struct BranchSched {
    const char* A; const char* B; int G, c;
    __device__ __forceinline__ bool next(int i, Unit& u) const { const int ti = i / 3, seg = i - 3 * ti; int pm, pn; if (!pg8::tile_of(ti * G + c, M / 256, D / 256, pm, pn)) return false;
        const int koff = seg == 0 ? 0 : (seg == 1 ? 1024 : 1536);
        u.A = A + ((size_t)pm * 256 * KBR + koff) * 2; u.B = B + ((size_t)pn * 256 * KBR + koff) * 2; u.nt = seg == 1 ? 8 : 16; u.pm = pm; u.pn = pn; u.aux = seg; return true; }
    __device__ __forceinline__ void a_ready(const Unit&) const {}
    __device__ __forceinline__ unsigned row_off(const Unit&, int) const { return 0u; }
};
struct PoolMixSched {
    const char* A; const char* B; int G, c;
    __device__ __forceinline__ bool next(int i, Unit& u) const { const int L = i * G + c; if (L >= 256) return false; const int pm = L >> 2, g = L & 3;
        u.A = A + ((size_t)pm * 256 * 1024 + g * 256) * 2; u.B = B + (size_t)g * 256 * 2; u.nt = 4; u.pm = pm; u.pn = g; u.aux = 0; return true; }
    __device__ __forceinline__ void a_ready(const Unit&) const {}
    __device__ __forceinline__ unsigned row_off(const Unit&, int) const { return 0u; }
};
struct MoeSched {
    const char* A; const char* B; const volatile LAS int* tab; const int* list; int nN, nt, G, c; size_t strideA, strideBe, strideBn; bool gather; unsigned rowbytes; int split = 0;
    __device__ __forceinline__ int tb(int k) const { return __builtin_amdgcn_readfirstlane(tab[k]); }
    __device__ __forceinline__ bool next(int i, Unit& u) const { const int NT = tb(8); int pm, pn; int L = i * G + c, sl = 0, tj = 0, ntu = nt;
        if (split) { const int U = NT * nN, full = U >> 8, R = U & 255;
            if (R > 0 && R <= 64 && i >= full) { if (i > full || c >= 4 * R) return false; sl = (c >= R ? 1 : 0) + (c >= 2 * R ? 1 : 0) + (c >= 3 * R ? 1 : 0); tj = c - sl * R + 1; L = (full << 8) + tj - 1; ntu = nt >> 2; } }
        if (!pg8::tile_of(L, NT, nN, pm, pn)) return false;
        int e = 0;
#pragma unroll
        for (int k = 1; k < 8; ++k) e += (pm >= tb(k)) ? 1 : 0;
        const size_t ko = (size_t)(sl * ntu) * 128;
        u.A = (gather ? A : A + (size_t)pm * strideA) + ko; u.B = B + (size_t)e * strideBe + (size_t)pn * strideBn + ko; u.nt = ntu; u.pm = pm; u.pn = pn; u.aux = e | (sl << 4) | (tj << 8); return true; }
    __device__ __forceinline__ void a_ready(const Unit&) const {}
    __device__ __forceinline__ unsigned row_off(const Unit& u, int r) const {
        const int e = u.aux, r0 = (u.pm - tb(e)) * 256, cnt = tb(16 + e); const int rr = (r0 + r < cnt) ? r0 + r : r0;
        return (unsigned)list[e * M + rr] * rowbytes; }
};

struct EpiInProj {
    static constexpr bool PERM = true;
    __device__ __forceinline__ bool keep(const Unit&) const { return false; }
    bf16* O; const float* cosT; const float* sinT;
    __device__ __forceinline__ void operator()(f32x4 (&acc)[2][2][4][2], const Unit& u, int wr, int wc, int fr, int fq) const {
        const int row0 = u.pm * 256 + wr * 64 + fr, col0 = (u.pn + ((GATES_FP8_COMPUTE && !GATES_TEST && u.pn >= C_P8 / 256) ? NV8 : 0)) * 256 + wc * 32 + 8 * fq;
        const int mode = (u.pn >= 34) ? 2 : ((u.pn >= 12 && u.pn < 24 && !(GATES_FP8_COMPUTE && !GATES_TEST && INPROJ_V8 == 2)) ? 1 : ((CONV_FUSE && u.pn >= 4 && u.pn < 12) ? 3 : 0));
        if (mode == 3) {
#pragma unroll
            for (int ai = 0; ai < 2; ++ai)
#pragma unroll
                for (int m = 0; m < 4; ++m) { const f32x4 v0 = acc[ai][0][m][0] * acc[ai][1][m][0], v1 = acc[ai][0][m][1] * acc[ai][1][m][1];
                    u32x4 w; w.x = cvt_pk_bf16(v0[0], v0[1]); w.y = cvt_pk_bf16(v0[2], v0[3]); w.z = cvt_pk_bf16(v1[0], v1[1]); w.w = cvt_pk_bf16(v1[2], v1[3]);
                    *(u32x4*)(O + (size_t)(row0 + ai * 128 + m * 16) * NIN + C_CC + (u.pn - 4) * 128 + wc * 32 + 8 * fq) = w; }
            return; }
#pragma unroll
        for (int ai = 0; ai < 2; ++ai)
#pragma unroll
            for (int m = 0; m < 4; ++m) { const int row = row0 + ai * 128 + m * 16; bf16* rowp = O + (size_t)row * NIN + col0;
                f32x4 c0 = {1.f, 1.f, 1.f, 1.f}, c1 = c0, s0 = {0.f, 0.f, 0.f, 0.f}, s1 = s0;
                if (mode == 1 && wc == 0) { const int pos = row & (SEQ - 1), j0 = 8 * (fq & 1);
                    c0 = *(const f32x4*)(cosT + pos * 16 + j0); c1 = *(const f32x4*)(cosT + pos * 16 + j0 + 4);
                    s0 = *(const f32x4*)(sinT + pos * 16 + j0); s1 = *(const f32x4*)(sinT + pos * 16 + j0 + 4);
                    if (fq < 2) { s0 = -s0; s1 = -s1; } }
#pragma unroll
                for (int bj = 0; bj < 2; ++bj) { f32x4 v0 = acc[ai][bj][m][0], v1 = acc[ai][bj][m][1];
                    if (mode == 1 && wc == 0) { f32x4 o0, o1;
#pragma unroll
                        for (int j = 0; j < 4; ++j) { o0[j] = __shfl_xor(v0[j], 32); o1[j] = __shfl_xor(v1[j], 32); }
                        v0 = v0 * c0 + o0 * s0; v1 = v1 * c1 + o1 * s1; }
                    if (mode == 2) {
#pragma unroll
                        for (int j = 0; j < 4; ++j) { v0[j] = fast_sigmoid(v0[j]); v1[j] = fast_sigmoid(v1[j]); } }
                    u32x4 w; w.x = cvt_pk_bf16(v0[0], v0[1]); w.y = cvt_pk_bf16(v0[2], v0[3]); w.z = cvt_pk_bf16(v1[0], v1[1]); w.w = cvt_pk_bf16(v1[2], v1[3]);
                    *(u32x4*)(rowp + bj * 128) = w; }
                asm volatile("" ::: "memory"); }
    }
};
struct EpiGate8 {
    static constexpr bool PERM = true;
    __device__ __forceinline__ bool keep(const Unit&) const { return false; }
    bf16* O; const float* cosT; const float* sinT;
    __device__ __forceinline__ void operator()(f32x4 (&acc)[2][2][4][2], const Unit& u, int wr, int wc, int fr, int fq) const {
        const int row0 = u.pm * 256 + wr * 64 + fr, col0 = (u.pn < NV8 ? C_P8 + u.pn * 256 : C_G + (u.pn - NV8) * 256) + wc * 32 + 8 * fq; const float is = -1.4426950408889634f / (F8_XS * F8_WGS);
        if (u.pn < NV8) {
            const float f = 1.0f / (F8_XS * F8_WGS); const bool rot = u.pn < NR8 && wc == 0;
#pragma unroll
            for (int ai = 0; ai < 2; ++ai)
#pragma unroll
                for (int m = 0; m < 4; ++m) { const int row = row0 + ai * 128 + m * 16; bf16* rowp = O + (size_t)row * NIN + col0;
                    f32x4 c0 = {1.f, 1.f, 1.f, 1.f}, c1 = c0, s0 = {0.f, 0.f, 0.f, 0.f}, s1 = s0;
                    if (rot) { const int pos = row & (SEQ - 1), j0 = 8 * (fq & 1);
                        c0 = *(const f32x4*)(cosT + pos * 16 + j0); c1 = *(const f32x4*)(cosT + pos * 16 + j0 + 4);
                        s0 = *(const f32x4*)(sinT + pos * 16 + j0); s1 = *(const f32x4*)(sinT + pos * 16 + j0 + 4);
                        if (fq < 2) { s0 = -s0; s1 = -s1; } }
#pragma unroll
                    for (int bj = 0; bj < 2; ++bj) { f32x4 v0 = acc[ai][bj][m][0] * f, v1 = acc[ai][bj][m][1] * f;
                        if (rot) { f32x4 o0, o1;
#pragma unroll
                            for (int j = 0; j < 4; ++j) { o0[j] = __shfl_xor(v0[j], 32); o1[j] = __shfl_xor(v1[j], 32); }
                            v0 = v0 * c0 + o0 * s0; v1 = v1 * c1 + o1 * s1; }
                        u32x4 w; w.x = cvt_pk_bf16(v0[0], v0[1]); w.y = cvt_pk_bf16(v0[2], v0[3]); w.z = cvt_pk_bf16(v1[0], v1[1]); w.w = cvt_pk_bf16(v1[2], v1[3]);
                        if (O) *(u32x4*)(rowp + bj * 128) = w; }
                    asm volatile("" ::: "memory"); }
            return; }
#pragma unroll
        for (int ai = 0; ai < 2; ++ai)
#pragma unroll
            for (int m = 0; m < 4; ++m) { bf16* rowp = O + (size_t)(row0 + ai * 128 + m * 16) * NIN + col0;
#pragma unroll
                for (int bj = 0; bj < 2; ++bj) { f32x4 v0 = acc[ai][bj][m][0], v1 = acc[ai][bj][m][1];
#pragma unroll
                    for (int j = 0; j < 4; j += 2) {
#if POLY_GATES
                        const f32x2 a0 = sigmoid_pk5((f32x2){v0[j], v0[j + 1]} * (1.0f / (F8_XS * F8_WGS))), a1 = sigmoid_pk5((f32x2){v1[j], v1[j + 1]} * (1.0f / (F8_XS * F8_WGS)));
                        v0[j] = fmaxf(a0.x, 1e-3f); v0[j + 1] = fmaxf(a0.y, 1e-3f); v1[j] = fmaxf(a1.x, 1e-3f); v1[j + 1] = fmaxf(a1.y, 1e-3f);
#else
                        v0[j] = __builtin_amdgcn_rcpf(1.0f + __builtin_amdgcn_exp2f(v0[j] * is)); v1[j] = __builtin_amdgcn_rcpf(1.0f + __builtin_amdgcn_exp2f(v1[j] * is));
                        v0[j + 1] = __builtin_amdgcn_rcpf(1.0f + __builtin_amdgcn_exp2f(v0[j + 1] * is)); v1[j + 1] = __builtin_amdgcn_rcpf(1.0f + __builtin_amdgcn_exp2f(v1[j + 1] * is));
#endif
                    }
                    u32x4 w; w.x = cvt_pk_bf16(v0[0], v0[1]); w.y = cvt_pk_bf16(v0[2], v0[3]); w.z = cvt_pk_bf16(v1[0], v1[1]); w.w = cvt_pk_bf16(v1[2], v1[3]);
                    if (O) *(u32x4*)(rowp + bj * 128) = w; }
                asm volatile("" ::: "memory"); }
    }
};
struct EpiBf16 {
    static constexpr bool PERM = true;
    __device__ __forceinline__ bool keep(const Unit&) const { return false; }
    bf16* O; int ldc, coff; const float* scale; float us = 1.0f;
    float* P = nullptr;
    __device__ __forceinline__ void operator()(f32x4 (&acc)[2][2][4][2], const Unit& u, int wr, int wc, int fr, int fq) const {
        const int row0 = u.pm * 256 + wr * 64 + fr, cl = u.pn * 256 + wc * 32 + 8 * fq;
        if (scale) {
            f32x4 sv[2][2];
#pragma unroll
            for (int bj = 0; bj < 2; ++bj)
#pragma unroll
                for (int n = 0; n < 2; ++n) sv[bj][n] = *(const f32x4*)(scale + cl + bj * 128 + 4 * n);
#pragma unroll
            for (int ai = 0; ai < 2; ++ai)
#pragma unroll
                for (int m = 0; m < 4; ++m) { bf16* rowp = O + (size_t)(row0 + ai * 128 + m * 16) * ldc + coff + cl;
#pragma unroll
                    for (int bj = 0; bj < 2; ++bj) { const f32x4 v0 = acc[ai][bj][m][0] * sv[bj][0], v1 = acc[ai][bj][m][1] * sv[bj][1];
                        u32x4 w; w.x = cvt_pk_bf16(v0[0], v0[1]); w.y = cvt_pk_bf16(v0[2], v0[3]); w.z = cvt_pk_bf16(v1[0], v1[1]); w.w = cvt_pk_bf16(v1[2], v1[3]);
                        *(u32x4*)(rowp + bj * 128) = w; }
                    asm volatile("" ::: "memory"); }
        } else {
            const float f = us;
            if (P && (u.aux >> 8)) { float* Pt = P + (size_t)(((u.aux >> 4) & 15) * 64 + (u.aux >> 8) - 1) * 65536 + (size_t)(wr * 64 + fr) * 256 + wc * 32 + 8 * fq;
#pragma unroll
                for (int ai = 0; ai < 2; ++ai)
#pragma unroll
                    for (int m = 0; m < 4; ++m) { float* rowp = Pt + (ai * 128 + m * 16) * 256;
#pragma unroll
                        for (int bj = 0; bj < 2; ++bj) { *(f32x4*)(rowp + bj * 128) = acc[ai][bj][m][0] * f; *(f32x4*)(rowp + bj * 128 + 4) = acc[ai][bj][m][1] * f; }
                        asm volatile("" ::: "memory"); }
                return; }
#pragma unroll
            for (int ai = 0; ai < 2; ++ai)
#pragma unroll
                for (int m = 0; m < 4; ++m) { bf16* rowp = O + (size_t)(row0 + ai * 128 + m * 16) * ldc + coff + cl;
#pragma unroll
                    for (int bj = 0; bj < 2; ++bj) { const f32x4 v0 = acc[ai][bj][m][0], v1 = acc[ai][bj][m][1];
                        u32x4 w; w.x = cvt_pk_bf16(v0[0] * f, v0[1] * f); w.y = cvt_pk_bf16(v0[2] * f, v0[3] * f); w.z = cvt_pk_bf16(v1[0] * f, v1[1] * f); w.w = cvt_pk_bf16(v1[2] * f, v1[3] * f);
                        *(u32x4*)(rowp + bj * 128) = w; }
                    asm volatile("" ::: "memory"); }
        }
    }
};
__device__ __forceinline__ unsigned pk4_fp8(float a, float b, float c, float d) {
    a = __builtin_amdgcn_fmed3f(a, -448.f, 448.f); b = __builtin_amdgcn_fmed3f(b, -448.f, 448.f); c = __builtin_amdgcn_fmed3f(c, -448.f, 448.f); d = __builtin_amdgcn_fmed3f(d, -448.f, 448.f);
    int w = 0; w = __builtin_amdgcn_cvt_pk_fp8_f32(a, b, w, false); w = __builtin_amdgcn_cvt_pk_fp8_f32(c, d, w, true); return (unsigned)w; }
struct EpiSwiGLU8 {
    static constexpr bool PERM = true;
    __device__ __forceinline__ bool keep(const Unit&) const { return false; }
    unsigned char* H; float is = 1.0f / (F8_XS * F8_WGS); int pn0 = 0;
    __device__ __forceinline__ void operator()(f32x4 (&acc)[2][2][4][2], const Unit& u, int wr, int wc, int fr, int fq) const {
        const int row0 = u.pm * 256 + wr * 64 + fr, col0 = (u.pn + pn0) * 128 + wc * 32 + 8 * fq;
#pragma unroll
        for (int ai = 0; ai < 2; ++ai)
#pragma unroll
            for (int m = 0; m < 4; ++m) { unsigned char* rowp = H + (size_t)(row0 + ai * 128 + m * 16) * FF + col0;
                f32x4 o[2];
#pragma unroll
                for (int n = 0; n < 2; ++n) {
#if POLY_SIGMOID
#pragma unroll
                    for (int j = 0; j < 4; j += 2) { const f32x2 g = (f32x2){acc[ai][0][m][n][j], acc[ai][0][m][n][j + 1]} * is, up = (f32x2){acc[ai][1][m][n][j], acc[ai][1][m][n][j + 1]} * (is * F8_HS);
                        const f32x2 h = g * sigmoid_pk4(g) * up; o[n][j] = h.x; o[n][j + 1] = h.y; }
#else
#pragma unroll
                    for (int j = 0; j < 4; ++j) { const float g = acc[ai][0][m][n][j] * is, up = acc[ai][1][m][n][j] * (is * F8_HS); o[n][j] = g * fast_sigmoid(g) * up; }
#endif
                }
                u32x2 w; w.x = pk4_fp8(o[0][0], o[0][1], o[0][2], o[0][3]); w.y = pk4_fp8(o[1][0], o[1][1], o[1][2], o[1][3]);
                *(u32x2*)rowp = w; asm volatile("" ::: "memory"); }
    }
};
struct EpiSwiGLU {
    static constexpr bool PERM = true;
    __device__ __forceinline__ bool keep(const Unit&) const { return false; }
    bf16* H;
    __device__ __forceinline__ void operator()(f32x4 (&acc)[2][2][4][2], const Unit& u, int wr, int wc, int fr, int fq) const {
        const int row0 = u.pm * 256 + wr * 64 + fr, col0 = u.pn * 128 + wc * 32 + 8 * fq;
#pragma unroll
        for (int ai = 0; ai < 2; ++ai)
#pragma unroll
            for (int m = 0; m < 4; ++m) { bf16* rowp = H + (size_t)(row0 + ai * 128 + m * 16) * FF + col0;
                f32x4 o[2];
#pragma unroll
                for (int n = 0; n < 2; ++n)
#pragma unroll
                    for (int j = 0; j < 4; ++j) { const float g = acc[ai][0][m][n][j], up = acc[ai][1][m][n][j]; o[n][j] = g * fast_sigmoid(g) * up; }
                u32x4 w; w.x = cvt_pk_bf16(o[0][0], o[0][1]); w.y = cvt_pk_bf16(o[0][2], o[0][3]); w.z = cvt_pk_bf16(o[1][0], o[1][1]); w.w = cvt_pk_bf16(o[1][2], o[1][3]);
                *(u32x4*)rowp = w; asm volatile("" ::: "memory"); }
    }
};
struct EpiBranch {
    static constexpr bool PERM = true;
    __device__ __forceinline__ bool keep(const Unit& u) const { return u.aux < 2; }
    const bf16* proj; bf16* O;
    __device__ __forceinline__ void operator()(f32x4 (&acc)[2][2][4][2], const Unit& u, int wr, int wc, int fr, int fq) const {
        const int seg = u.aux, row0 = u.pm * 256 + wr * 64 + fr, cl = u.pn * 256 + wc * 32 + 8 * fq;
        const bf16* gp0 = proj + (size_t)row0 * NIN + C_G + seg * D + cl;
        u32x4 gc[2], gd[2], gcn[2], gdn[2];
#pragma unroll
        for (int bj = 0; bj < 2; ++bj) { gc[bj] = *(const u32x4*)(gp0 + bj * 128); gd[bj] = gc[bj]; if (seg < 2) gd[bj] = *(const u32x4*)(gp0 + D + bj * 128); }
#pragma unroll
        for (int ai = 0; ai < 2; ++ai)
#pragma unroll
            for (int m = 0; m < 4; ++m) { const int row = row0 + ai * 128 + m * 16;
                if (!(ai == 1 && m == 3)) { const bf16* gpn = gp0 + (size_t)(m == 3 ? 128 : ai * 128 + (m + 1) * 16) * NIN;
#pragma unroll
                    for (int bj = 0; bj < 2; ++bj) { gcn[bj] = *(const u32x4*)(gpn + bj * 128); gdn[bj] = gcn[bj]; if (seg < 2) gdn[bj] = *(const u32x4*)(gpn + D + bj * 128); } }
#pragma unroll
                for (int bj = 0; bj < 2; ++bj) { float g[8]; unpack8(gc[bj], g);
                    if (seg < 2) { float gn[8]; unpack8(gd[bj], gn);
#pragma unroll
                        for (int j = 0; j < 8; ++j) g[j] *= __builtin_amdgcn_rcpf(fmaxf(gn[j], 1e-30f)); }
                    f32x4 v0 = acc[ai][bj][m][0], v1 = acc[ai][bj][m][1];
                    v0[0] *= g[0]; v0[1] *= g[1]; v0[2] *= g[2]; v0[3] *= g[3]; v1[0] *= g[4]; v1[1] *= g[5]; v1[2] *= g[6]; v1[3] *= g[7];
                    if (seg < 2) { acc[ai][bj][m][0] = v0; acc[ai][bj][m][1] = v1; }
                    else { u32x4 w; w.x = cvt_pk_bf16(v0[0], v0[1]); w.y = cvt_pk_bf16(v0[2], v0[3]); w.z = cvt_pk_bf16(v1[0], v1[1]); w.w = cvt_pk_bf16(v1[2], v1[3]);
                        *(u32x4*)(O + (size_t)row * D + cl + bj * 128) = w; } }
#pragma unroll
                for (int bj = 0; bj < 2; ++bj) { gc[bj] = gcn[bj]; gd[bj] = gdn[bj]; }
                asm volatile("" ::: "memory"); }
    }
};
struct EpiNone {
    static constexpr bool PERM = true;
    __device__ __forceinline__ bool keep(const Unit&) const { return false; }
    float* sink;
    __device__ __forceinline__ void operator()(f32x4 (&acc)[2][2][4][2], const Unit& u, int wr, int wc, int fr, int fq) const {
        f32x4 t = acc[0][0][0][0];
#pragma unroll
        for (int ai = 0; ai < 2; ++ai)
#pragma unroll
            for (int bj = 0; bj < 2; ++bj)
#pragma unroll
                for (int m = 0; m < 4; ++m)
#pragma unroll
                    for (int n = 0; n < 2; ++n) t += acc[ai][bj][m][n];
        if (t[0] + t[1] + t[2] + t[3] == 123.456f) sink[threadIdx.x] = t[0]; }
};
struct EpiResid {
    static constexpr bool PERM = true;
    __device__ __forceinline__ bool keep(const Unit&) const { return false; }
    const bf16* X; bf16* R; float us = 1.0f;
    __device__ __forceinline__ void operator()(f32x4 (&acc)[2][2][4][2], const Unit& u, int wr, int wc, int fr, int fq) const {
        const int row0 = u.pm * 256 + wr * 64 + fr, cl = u.pn * 256 + wc * 32 + 8 * fq;
        u32x4 xc[2], xn[2];
        { const size_t off = (size_t)row0 * D + cl; xc[0] = *(const u32x4*)(X + off); xc[1] = *(const u32x4*)(X + off + 128); }
#pragma unroll
        for (int ai = 0; ai < 2; ++ai)
#pragma unroll
            for (int m = 0; m < 4; ++m) { const size_t off = (size_t)(row0 + ai * 128 + m * 16) * D + cl;
                if (!(ai == 1 && m == 3)) { const size_t offn = (size_t)(row0 + (m == 3 ? 128 : ai * 128 + (m + 1) * 16)) * D + cl; xn[0] = *(const u32x4*)(X + offn); xn[1] = *(const u32x4*)(X + offn + 128); }
#pragma unroll
                for (int bj = 0; bj < 2; ++bj) { float f[8]; unpack8(xc[bj], f); const f32x4 a0 = acc[ai][bj][m][0], a1 = acc[ai][bj][m][1];
                    u32x4 w; w.x = cvt_pk_bf16(f[0] * ALPHA + a0[0] * us, f[1] * ALPHA + a0[1] * us); w.y = cvt_pk_bf16(f[2] * ALPHA + a0[2] * us, f[3] * ALPHA + a0[3] * us);
                    w.z = cvt_pk_bf16(f[4] * ALPHA + a1[0] * us, f[5] * ALPHA + a1[1] * us); w.w = cvt_pk_bf16(f[6] * ALPHA + a1[2] * us, f[7] * ALPHA + a1[3] * us);
                    *(u32x4*)(R + off + bj * 128) = w; }
                xc[0] = xn[0]; xc[1] = xn[1];
                asm volatile("" ::: "memory"); }
    }
};

struct Ctx { LAS unsigned char* lds; int tid, lane, wave, G, vcu; };

template <bool F8>
__device__ __forceinline__ void transpose_job(const float* W, int ldn, int nblk, int items, bf16* WT, int ldt, int coloff, int mode, float scale, LAS float* scr, int gw, int NGW, int lane) {
    constexpr int NL = (F8 && F8_K128) ? 16 : 8, KB = 8 * NL;
    f32x4 cur[NL], nxt[NL]; const int lr = lane >> 3, lc = 4 * (lane & 7);
    int it = gw;
    if (it < items) { const float* p = W + (size_t)(KB * (it / nblk) + lr) * ldn + 32 * (it % nblk) + lc;
#pragma unroll
        for (int i = 0; i < NL; ++i) cur[i] = *(const f32x4*)(p + (size_t)(8 * i) * ldn); }
    for (; it < items; it += NGW) {
        const int itn = it + NGW;
        if (itn < items) { const float* p = W + (size_t)(KB * (itn / nblk) + lr) * ldn + 32 * (itn % nblk) + lc;
#pragma unroll
            for (int i = 0; i < NL; ++i) nxt[i] = *(const f32x4*)(p + (size_t)(8 * i) * ldn); }
        const int k0 = KB * (it / nblk), n0 = 32 * (it % nblk);
        if constexpr (NL == 16) {
#pragma unroll
            for (int i = 0; i < 16; ++i) *(LAS f32x4*)(scr + (8 * i + lr) * 32 + (lc ^ (4 * (i >> 1)))) = cur[i];
        } else {
#pragma unroll
        for (int i = 0; i < 8; ++i) { LAS float* d = scr + (8 * i + lr) * 33 + lc; d[0] = cur[i][0]; d[1] = cur[i][1]; d[2] = cur[i][2]; d[3] = cur[i][3]; }
        }
        LDS_WAIT(); asm volatile("" ::: "memory");
        const int c = lane & 7;
#pragma unroll
        for (int j = 0; j < 4; ++j) { const int n = (lane >> 3) + 8 * j; const LAS float* sp = scr + (8 * c) * 33 + n; const int nc = n0 + n;
            int drow = mode == 0 ? nc : (mode == 3 ? ((nc < 1024 || nc >= 3072) ? nc : 1024 + (((nc - 1024) & 1023) >> 7) * 256 + (nc & 127) + (nc >= 2048 ? 128 : 0)) : ((nc >> 7) * 256 + (nc & 127) + (mode == 2 ? 128 : 0)));
            bool skip = false;
            if (INPROJ_V8 && mode == 3 && nc >= C_P8) { skip = nc < C_PU; drow = nc - (C_PU - C_P8); }
            if (mode == 4) { skip = nc >= C_PU - C_P8 && nc < C_G - C_P8; drow = nc < C_PU - C_P8 ? nc : nc - (C_G - C_PU); }
            if constexpr (NL == 16) { const LAS float* s8 = scr + (16 * c) * 32 + (n ^ (4 * c)); u32x4 o;
                o.x = pk4_fp8(s8[0 * 32] * scale, s8[1 * 32] * scale, s8[2 * 32] * scale, s8[3 * 32] * scale); o.y = pk4_fp8(s8[4 * 32] * scale, s8[5 * 32] * scale, s8[6 * 32] * scale, s8[7 * 32] * scale);
                o.z = pk4_fp8(s8[8 * 32] * scale, s8[9 * 32] * scale, s8[10 * 32] * scale, s8[11 * 32] * scale); o.w = pk4_fp8(s8[12 * 32] * scale, s8[13 * 32] * scale, s8[14 * 32] * scale, s8[15 * 32] * scale);
                if (!skip) *(u32x4*)((unsigned char*)WT + (size_t)drow * ldt + coloff + k0 + 16 * c) = o; }
            else if (F8) { u32x2 o; o.x = pk4_fp8(sp[0 * 33] * scale, sp[1 * 33] * scale, sp[2 * 33] * scale, sp[3 * 33] * scale); o.y = pk4_fp8(sp[4 * 33] * scale, sp[5 * 33] * scale, sp[6 * 33] * scale, sp[7 * 33] * scale);
                if (!skip) *(u32x2*)((unsigned char*)WT + (size_t)drow * ldt + coloff + k0 + 8 * c) = o; }
            else { u32x4 o; o.x = cvt_pk_bf16(sp[0 * 33], sp[1 * 33]); o.y = cvt_pk_bf16(sp[2 * 33], sp[3 * 33]); o.z = cvt_pk_bf16(sp[4 * 33], sp[5 * 33]); o.w = cvt_pk_bf16(sp[6 * 33], sp[7 * 33]);
                if (!skip) *(u32x4*)(WT + (size_t)drow * ldt + coloff + k0 + 8 * c) = o; } }
        LDS_WAIT(); asm volatile("" ::: "memory");
#pragma unroll
        for (int i = 0; i < NL; ++i) cur[i] = nxt[i];
    }
}
struct Job { const float* src; bf16* dst; int K, N, ldn, ldt, coloff, mode; float f8scale; };
__device__ __forceinline__ Job get_job(const Args& a, int j) {
    Job J; unsigned char* ws = a.ws; J.f8scale = 0.f;
    if (j >= 41) {
        J.src = (j == 41 ? a.in[11] : a.in[12]) + (56 - DENSE_UP8_TILES) * 128; J.dst = (bf16*)(ws + WS_FFN0 + FFN_WGU + (size_t)(56 - DENSE_UP8_TILES) * 256 * D * 2);
        J.K = D; J.N = DENSE_UP8_TILES * 128; J.ldn = FF; J.ldt = D; J.coloff = 0; J.mode = j == 41 ? 1 : 2; J.f8scale = F8_WGS; return J; }
    if (j < 14) { const int l = j / 7, k = j - 7 * l, ib = l ? 16 : 1; unsigned char* wl = ws + WS_WL + (size_t)l * WL_STRIDE;
        if (k == 0)      { J.src = a.in[ib + 0]; J.dst = (bf16*)(wl + WL_WIN); J.K = D;    J.N = (GATES_FP8_COMPUTE && !GATES_TEST && (GATES_L0 || l == 1)) ? C_G : NIN; J.ldt = D;    J.coloff = 0;    J.mode = CONV_FUSE ? 3 : 0; J.ldn = NIN; return J; }
        else if (k == 6) { J.src = a.in[ib + 0] + (INPROJ_V8 ? C_P8 : C_G); J.dst = (bf16*)(ws + WS_Y + (96 + 21 * l) * MiB); J.K = D; J.N = GATES_FP8 ? NIN - (INPROJ_V8 ? C_P8 : C_G) : 0; J.ldt = D; J.coloff = 0; J.mode = INPROJ_V8 ? 4 : 0; J.ldn = NIN; J.f8scale = F8_WGS; return J; }
        else if (k == 1) { J.src = a.in[ib + 2]; J.dst = (bf16*)(wl + WL_WBR); J.K = 1024; J.N = D;   J.ldt = KBR;  J.coloff = 0;    J.mode = 0; }
        else if (k == 2) { J.src = a.in[ib + 3]; J.dst = (bf16*)(wl + WL_WBR); J.K = 512;  J.N = D;   J.ldt = KBR;  J.coloff = 1024; J.mode = 0; }
        else if (k == 3) { J.src = a.in[ib + 6]; J.dst = (bf16*)(wl + WL_WBR); J.K = 1024; J.N = D;   J.ldt = KBR;  J.coloff = 1536; J.mode = 0; }
        else if (k == 4) { J.src = a.in[ib + 4]; J.dst = (bf16*)(wl + WL_PM);  J.K = 1024; J.N = 256; J.ldt = 1024; J.coloff = 0;    J.mode = 0; }
        else             { J.src = a.in[ib + 7]; J.dst = (bf16*)(wl + WL_WO);  J.K = D;    J.N = D;   J.ldt = D;    J.coloff = 0;    J.mode = 0; }
        J.ldn = J.N; return J; }
    j -= 14;
    const int e = j < 3 ? 0 : (j - 3) / 3, k = j < 3 ? j : (j - 3) % 3;
    unsigned char* wf = j < 3 ? ws + WS_FFN0 : ws + WS_MOE + (size_t)e * FFN_STRIDE;
    const float* g = j < 3 ? a.in[11] : a.in[27] + (size_t)e * D * FF; const float* up = j < 3 ? a.in[12] : a.in[28] + (size_t)e * D * FF; const float* dn = j < 3 ? a.in[13] : a.in[29] + (size_t)e * D * FF;
    if (k == 0)      { J.src = g;  J.dst = (bf16*)(wf + FFN_WGU); J.K = D;  J.N = FF; J.ldt = D;  J.coloff = 0; J.mode = 1; }
    else if (k == 1) { J.src = up; J.dst = (bf16*)(wf + FFN_WGU); J.K = D;  J.N = FF; J.ldt = D;  J.coloff = 0; J.mode = 2; }
    else             { J.src = dn; J.dst = (bf16*)(wf + FFN_WD);  J.K = FF; J.N = D;  J.ldt = FF; J.coloff = 0; J.mode = 0; }
    if ((MOE_FP8 && j >= 3) || (DENSE_FP8 && j < 3) || (DENSE_DOWN_FP8 && j == 2)) J.f8scale = (k == 2) ? F8_WDS : F8_WGS;
    J.ldn = J.N;
    if (DENSE_UP8_TILES && j < 2) J.N = (56 - DENSE_UP8_TILES) * 128;
    return J;
}
__device__ __forceinline__ void sincos_f64(double r, double& s, double& c) {
    const double hp = 1.57079632679489661923; const double kq = __builtin_rint(r / hp); const double y = r - kq * hp; const int q = ((int)kq) & 3; const double y2 = y * y;
    double sp = -7.6471637318198164759e-13; sp = sp * y2 + 1.6059043836821614599e-10; sp = sp * y2 - 2.5052108385441718775e-8; sp = sp * y2 + 2.7557319223985890653e-6; sp = sp * y2 - 1.9841269841269841270e-4; sp = sp * y2 + 8.3333333333333333333e-3; sp = sp * y2 - 1.6666666666666666667e-1; const double sy = y + y * y2 * sp;
    double cp = 4.7794773323873852974e-14; cp = cp * y2 - 1.1470745597729724714e-11; cp = cp * y2 + 2.0876756987868098979e-9; cp = cp * y2 - 2.7557319223985890653e-7; cp = cp * y2 + 2.4801587301587301587e-5; cp = cp * y2 - 1.3888888888888888889e-3; cp = cp * y2 + 4.1666666666666666667e-2; cp = cp * y2 - 0.5; const double cy = 1.0 + y2 * cp;
    s = (q == 0) ? sy : (q == 1) ? cy : (q == 2) ? -sy : -cy; c = (q == 0) ? cy : (q == 1) ? -sy : (q == 2) ? -cy : sy;
}
__device__ __forceinline__ void p_prologue(const Args& a, const Ctx& F, const int jlo, const int jhi) {
    LAS float* scr = (LAS float*)(F.lds + F.wave * 16384);
    const int gw = F.vcu * 8 + F.wave, NGW = F.G * 8;
    int base = 0;
    for (int j = jlo; j < jhi; ++j) { const Job J = get_job(a, j); const int nblk = J.N / 32, items = (J.K / ((F8_K128 && J.f8scale > 0.f) ? 128 : 64)) * nblk;
        const int first = (gw - base % NGW + NGW) % NGW;
        if (J.f8scale > 0.f) transpose_job<true>(J.src, J.ldn, nblk, items, J.dst, J.ldt, J.coloff, J.mode, J.f8scale, scr, first, NGW, F.lane);
        else transpose_job<false>(J.src, J.ldn, nblk, items, J.dst, J.ldt, J.coloff, J.mode, 1.f, scr, first, NGW, F.lane);
        base += items; }
    { const float* x = a.in[0]; bf16* xb = (bf16*)(a.ws + WS_XB); const size_t n8 = (size_t)M * D / 8;
      for (size_t i = (size_t)blockIdx.x * 512 + F.tid; i < n8; i += (size_t)F.G * 512) { const f32x4 v0 = *(const f32x4*)(x + i * 8), v1 = *(const f32x4*)(x + i * 8 + 4);
          u32x4 w; w.x = cvt_pk_bf16(v0[0], v0[1]); w.y = cvt_pk_bf16(v0[2], v0[3]); w.z = cvt_pk_bf16(v1[0], v1[1]); w.w = cvt_pk_bf16(v1[2], v1[3]); *(u32x4*)(xb + i * 8) = w;
          if (GATES_FP8) { u32x2 w8; w8.x = pk4_fp8(v0[0] * F8_XS, v0[1] * F8_XS, v0[2] * F8_XS, v0[3] * F8_XS); w8.y = pk4_fp8(v1[0] * F8_XS, v1[1] * F8_XS, v1[2] * F8_XS, v1[3] * F8_XS); *(u32x2*)(a.ws + WS_ATT + i * 8) = w8; } } }
    { float* cosT = (float*)(a.ws + WS_ROT); float* sinT = cosT + SEQ * 16;
      for (int i = blockIdx.x * 512 + F.tid; i < SEQ * 16; i += F.G * 512) { const int pos = i >> 4, j = i & 15; const float ang = (float)pos * a.inv_freq[j];
          const double tp = 6.28318530717958647692; const double ad = (double)ang; const double r = ad - tp * __builtin_rint(ad / tp); double s, c; sincos_f64(r, s, c); cosT[i] = (float)c; sinT[i] = (float)s; } }
}

__device__ __forceinline__ unsigned vtile_off(unsigned row, unsigned ch) { return 256u * row + 16u * (ch ^ (((row & 3u) << 2) | ((row >> 2) & 3u))); }
__device__ __forceinline__ s16x4 tr16(LAS unsigned char* p) { typedef short v4i16_t __attribute__((ext_vector_type(4))); return __builtin_bit_cast(s16x4, __builtin_amdgcn_ds_read_tr16_b64_v4i16((LAS v4i16_t*)p)); }
__device__ __forceinline__ void attn_unit(const Ctx& F, const bf16* proj, bf16* att, float* lse, int unit) {
    const int g = unit >> 9, rem = unit & 511, b = rem >> 7, hg = (rem >> 5) & 3, cb = rem & 31;
    const int dsh = 2 * g, d = 1 << dsh, nblk = 32 >> dsh, c = cb / nblk, blk = cb % nblk, L = SEQ >> dsh, L0 = blk * 128, head = g * 4 + hg;
    const bf16* pb = proj + (size_t)b * SEQ * NIN;
    LAS unsigned char* vt = F.lds;
    u32x4 vr[9];
#pragma unroll
    for (int it = 0; it < 9; ++it) { int ch = F.tid + 512 * it; ch = ch < 272 * 16 ? ch : 272 * 16 - 1; const int row = ch >> 4, c16 = ch & 15; int sub = L0 - 128 + row; sub = sub < 0 ? 0 : (sub > L - 1 ? L - 1 : sub);
        vr[it] = *(const u32x4*)(pb + (size_t)(sub * d + c) * NIN + C_V + head * 128 + c16 * 8); }
#pragma unroll
    for (int it = 0; it < 9; ++it) { const int ch = F.tid + 512 * it; const int row = ch >> 4, c16 = ch & 15, sub = L0 - 128 + row; u32x4 v = vr[it];
        if (!(sub >= 0 && sub < L)) v = (u32x4){0u, 0u, 0u, 0u};
        if (ch < 272 * 16) *(LAS u32x4*)(vt + vtile_off(row, c16)) = v; }
    const int lane = F.lane, w = F.wave, q = lane & 15, g4 = lane >> 4, l0 = L0 + 16 * w, kwin0 = l0 - 128;
    const size_t qrow = (size_t)((l0 + q) * d + c);
    bf16x8 qf[4];
#pragma unroll
    for (int s = 0; s < 4; ++s) qf[s] = *(const bf16x8*)(pb + qrow * NIN + C_Q + head * 128 + 32 * s + 8 * g4);
    bf16x8 kf[2][4], kn[2][4];
#define ATT_KLOAD(dst, ks) do { _Pragma("unroll") for (int t = 0; t < 2; ++t) { int ksub = kwin0 + 32 * (ks) + 8 * (q >> 2) + 4 * t + (q & 3); ksub = ksub < 0 ? 0 : (ksub > L - 1 ? L - 1 : ksub); \
        const bf16* kp = pb + (size_t)(ksub * d + c) * NIN + C_K + head * 128 + 8 * g4; _Pragma("unroll") for (int s = 0; s < 4; ++s) dst[t][s] = *(const bf16x8*)(kp + 32 * s); } } while (0)
    ATT_KLOAD(kf, 0);
    __syncthreads();
    f32x4 S[5][2];
#pragma unroll
    for (int ks = 0; ks < 5; ++ks) {
        if (ks < 4) { ATT_KLOAD(kn, ks + 1); }
        __builtin_amdgcn_sched_barrier(0);
#pragma unroll
        for (int t = 0; t < 2; ++t) { f32x4 sa = {0.f, 0.f, 0.f, 0.f};
#pragma unroll
            for (int s = 0; s < 4; ++s) sa = __builtin_amdgcn_mfma_f32_16x16x32_bf16(kf[t][s], qf[s], sa, 0, 0, 0);
            S[ks][t] = sa; }
        __builtin_amdgcn_sched_barrier(0);
        if (ks < 4) {
#pragma unroll
            for (int t = 0; t < 2; ++t)
#pragma unroll
                for (int s = 0; s < 4; ++s) kf[t][s] = kn[t][s]; }
    }
#undef ATT_KLOAD
    const float sc = 0.08838834764831845f * 1.4426950408889634f; float mx = -1e30f;
#pragma unroll
    for (int ks = 0; ks < 5; ++ks)
#pragma unroll
        for (int t = 0; t < 2; ++t)
#pragma unroll
            for (int r = 0; r < 4; ++r) { const int jj = 32 * ks + 8 * g4 + 4 * t + r; const bool ok = (jj >= q) && (jj <= q + 128) && (kwin0 + jj >= 0);
                const float v = ok ? S[ks][t][r] * sc : -1e30f; S[ks][t][r] = v; mx = fmaxf(mx, v); }
    mx = fmaxf(mx, __shfl_xor(mx, 16)); mx = fmaxf(mx, __shfl_xor(mx, 32));
    float sum = 0.f; bf16x8 pf[5];
#pragma unroll
    for (int ks = 0; ks < 5; ++ks) { float p[8];
#pragma unroll
        for (int t = 0; t < 2; ++t)
#pragma unroll
            for (int r = 0; r < 4; ++r) { const float e = __builtin_amdgcn_exp2f(S[ks][t][r] - mx); p[4 * t + r] = e; sum += e; }
        const u32x4 pw = pack8(p); pf[ks] = __builtin_bit_cast(bf16x8, pw); }
    sum += __shfl_xor(sum, 16); sum += __shfl_xor(sum, 32);
    const float inv = 1.0f / sum;
    const unsigned trq = (lane & 15) >> 2, trp = lane & 3;
    const unsigned rb0 = 16u * w + 8u * g4 + trq, xlo = (trq << 2) | ((2u * g4) & 3u), xhi = (trq << 2) | ((2u * g4 + 1u) & 3u);
    LAS unsigned char* vlo = vt + 256u * rb0 + 8u * (trp & 1); LAS unsigned char* vhi = vlo + 1024u;
    bf16* op = att + ((size_t)g * M + (size_t)b * SEQ + qrow) * 512 + hg * 128 + 4 * g4;
#pragma unroll
    for (int cc = 0; cc < 8; ++cc) { f32x4 o = {0.f, 0.f, 0.f, 0.f};
        const unsigned ch = 2u * cc + (trp >> 1); LAS unsigned char* plo = vlo + 16u * (ch ^ xlo); LAS unsigned char* phi = vhi + 16u * (ch ^ xhi);
#pragma unroll
        for (int ks = 0; ks < 5; ++ks) {
            const s16x4 lo = tr16(plo + 8192 * ks), hi = tr16(phi + 8192 * ks);
            const bf16x8 vf = {lo[0], lo[1], lo[2], lo[3], hi[0], hi[1], hi[2], hi[3]};
            o = __builtin_amdgcn_mfma_f32_16x16x32_bf16(vf, pf[ks], o, 0, 0, 0); }
        u32x2 ow; ow.x = cvt_pk_bf16(o[0] * inv, o[1] * inv); ow.y = cvt_pk_bf16(o[2] * inv, o[3] * inv); *(u32x2*)(op + 16 * cc) = ow; }
    if (g4 == 0) lse[((size_t)g * M + (size_t)b * SEQ + qrow) * 4 + hg] = mx + __builtin_amdgcn_logf(sum);
    __syncthreads();
}
__device__ __forceinline__ void p_mixA(const Args& a, const Ctx& F, int layer, const int sub_reps) {
    const bf16* proj = (const bf16*)(a.ws + WS_BIG + BIG_PROJ); bf16* att = (bf16*)(a.ws + WS_ATT); float* lse = (float*)(a.ws + WS_LSE);
    for (int r_ = 0; r_ < ((sub_reps == 1) ? 2 : 1); ++r_)
    for (int u = blockIdx.x; u < 1536; u += F.G) attn_unit(F, proj, att, lse, u);
    bf16* pooled = (bf16*)(a.ws + WS_Y + Y_POOLED);
    for (int r_ = 0; r_ < ((sub_reps == 2) ? 2 : 1); ++r_)
    for (int blk = blockIdx.x; blk < M / 64; blk += F.G)
    for (int it = 0; it < 4; ++it) { const int c8 = F.tid & 127, r0 = blk * 64 + (it * 4 + (F.tid >> 7)) * 4, t0 = r0 & (SEQ - 1), gi = c8 >> 5, w = 2 << gi;
        const bf16* p = proj + (size_t)(r0 + 3) * NIN + C_PU + c8 * 8; u32x4 raw[19];
#pragma unroll
        for (int k = 0; k < 19; ++k) { raw[k] = (u32x4){0u, 0u, 0u, 0u}; if (k < w + 3 && t0 + 3 - k >= 0) raw[k] = *(const u32x4*)(p - (size_t)k * NIN); }
        float o[4][8];
#pragma unroll
        for (int j = 0; j < 4; ++j)
#pragma unroll
            for (int e = 0; e < 8; ++e) o[j][e] = 0.f;
#pragma unroll
        for (int k = 0; k < 19; ++k) { float f[8]; unpack8(raw[k], f);
#pragma unroll
            for (int j = 0; j < 4; ++j) { const bool in = (k >= 3 - j) && (k < 3 - j + w);
#pragma unroll
                for (int e = 0; e < 8; ++e) o[j][e] += in ? f[e] : 0.f; } }
#pragma unroll
        for (int j = 0; j < 4; ++j) { const int t = t0 + j; const int n = (t + 1 < w) ? t + 1 : w; const float rn = 1.0f / (float)n; float cur[8], res[8]; unpack8(raw[3 - j], cur);
#pragma unroll
            for (int e = 0; e < 8; ++e) res[e] = o[j][e] * rn - cur[e];
            *(u32x4*)(pooled + (size_t)(r0 + j) * 1024 + c8 * 8) = pack8(res); } }
    const float* cw = a.in[(layer ? 16 : 1) + 1]; bf16* abr = (bf16*)(a.ws + WS_BIG + BIG_ABR);
    for (int r_ = 0; r_ < ((sub_reps == 3) ? 2 : 1); ++r_)
    for (int blk = blockIdx.x; blk < M / 64; blk += F.G)
    for (int it = 0; it < 4; ++it) { const int c8 = F.tid & 127, r0 = blk * 64 + (it * 4 + (F.tid >> 7)) * 4, t0 = r0 & (SEQ - 1);
        const bf16* p = proj + (size_t)r0 * NIN + c8 * 8; u32x4 rc[6], rh[6], rb[4];
#pragma unroll
        for (int k = 0; k < 6; ++k) { rc[k] = (u32x4){0u, 0u, 0u, 0u}; rh[k] = rc[k]; if (t0 + k - 2 >= 0) { rc[k] = *(const u32x4*)(p + C_CC + (ptrdiff_t)(k - 2) * NIN); if (!CONV_FUSE) rh[k] = *(const u32x4*)(p + C_CH + (ptrdiff_t)(k - 2) * NIN); } }
#pragma unroll
        for (int j = 0; j < 4; ++j) rb[j] = *(const u32x4*)(p + C_CB + (size_t)j * NIN);
        float wv[3][8];
#pragma unroll
        for (int k = 0; k < 3; ++k) { const f32x4 w0 = *(const f32x4*)(cw + k * 1024 + c8 * 8), w1 = *(const f32x4*)(cw + k * 1024 + c8 * 8 + 4);
#pragma unroll
            for (int e = 0; e < 4; ++e) { wv[k][e] = w0[e]; wv[k][4 + e] = w1[e]; } }
        float uu[6][8];
#pragma unroll
        for (int k = 0; k < 6; ++k) { float cc[8], ch[8]; unpack8(rc[k], cc); unpack8(rh[k], ch);
#pragma unroll
            for (int e = 0; e < 8; ++e) uu[k][e] = CONV_FUSE ? cc[e] : cc[e] * ch[e]; }
#pragma unroll
        for (int j = 0; j < 4; ++j) { float cbv[8], res[8]; unpack8(rb[j], cbv);
#pragma unroll
            for (int e = 0; e < 8; ++e) res[e] = cbv[e] * (wv[0][e] * uu[j][e] + wv[1][e] * uu[j + 1][e] + wv[2][e] * uu[j + 2][e]);
            *(u32x4*)(abr + (size_t)(r0 + j) * KBR + c8 * 8) = pack8(res); } }
}
__device__ __forceinline__ void p_combine(const Args& a, const Ctx& F) {
    const bf16* att = (const bf16*)(a.ws + WS_ATT); const float* lse = (const float*)(a.ws + WS_LSE); bf16* abr = (bf16*)(a.ws + WS_BIG + BIG_ABR);
    for (int i = blockIdx.x * 512 + F.tid; i < M * 64; i += F.G * 512) { const int row = i >> 6, c8 = i & 63, hg = c8 >> 4;
        const float l0 = lse[((size_t)0 * M + row) * 4 + hg], l1 = lse[((size_t)1 * M + row) * 4 + hg], l2 = lse[((size_t)2 * M + row) * 4 + hg];
        const float mx = fmaxf(l0, fmaxf(l1, l2)); float w0 = __builtin_amdgcn_exp2f(l0 - mx), w1 = __builtin_amdgcn_exp2f(l1 - mx), w2 = __builtin_amdgcn_exp2f(l2 - mx); const float inv = 1.0f / (w0 + w1 + w2); w0 *= inv; w1 *= inv; w2 *= inv;
        float f0[8], f1[8], f2[8], o[8]; unpack8(*(const u32x4*)(att + ((size_t)0 * M + row) * 512 + c8 * 8), f0); unpack8(*(const u32x4*)(att + ((size_t)1 * M + row) * 512 + c8 * 8), f1); unpack8(*(const u32x4*)(att + ((size_t)2 * M + row) * 512 + c8 * 8), f2);
#pragma unroll
        for (int j = 0; j < 8; ++j) o[j] = w0 * f0[j] + w1 * f1[j] + w2 * f2[j];
        *(u32x4*)(abr + (size_t)row * KBR + 1024 + c8 * 8) = pack8(o); }
}

template <int MODE, bool F8OUT>
__device__ __forceinline__ void p_layernorm(const Args& a, const Ctx& F, const float* gam, const float* bet, const float* wr, const bool dummy) {
    const bf16* XBi = (const bf16*)(a.ws + WS_XB); bf16* XB = dummy ? (bf16*)(a.ws + WS_BIG + 400 * MiB) : (bf16*)(a.ws + WS_XB); float* Ro = dummy ? (float*)(a.ws + WS_BIG + 256 * MiB) : a.out;
    gu32* ctl = (gu32*)(a.ws + WS_CTL); unsigned char* X8 = dummy ? (a.ws + WS_BIG + 464 * MiB) : (a.ws + WS_ATT);
    int* list = (int*)(a.ws + WS_LIST); unsigned* info = (unsigned*)(a.ws + WS_INFO); const bf16* Y = (const bf16*)(a.ws + WS_Y);
    volatile LAS int* tab = (volatile LAS int*)(F.lds + TAB_OFF);
    LAS f32x4* wl = (LAS f32x4*)(F.lds + 0);
    LAS int* lcnt = (LAS int*)(F.lds + 65536); LAS int* lbase = (LAS int*)(F.lds + 65536 + 64); LAS unsigned* sel = (LAS unsigned*)(F.lds + 65536 + 128);
    const int lane = F.lane;
    if (MODE == 2) {
        if (F.tid == 0) { int s = 0; for (int e = 0; e < 8; ++e) { const int cnt = (int)__hip_atomic_load(ctl + CW_CNT + 64 * e, RLX_AGENT); tab[e] = s; tab[16 + e] = cnt; s += (cnt + 255) >> 8; } tab[8] = s; }
        __syncthreads(); }
    if (MODE == 1) {
        for (int i = F.tid; i < D * 2; i += 512) { const int d = i >> 1, half = i & 1, l = (d & 255) >> 2, j = d >> 8, k = d & 3;
            wl[((j * 4 + k) * 2 + half) * 64 + l] = *(const f32x4*)(wr + (size_t)d * 8 + half * 4); }
        __syncthreads(); }
    f32x4 gv[8], bv[8];
#pragma unroll
    for (int j = 0; j < 8; ++j) { gv[j] = *(const f32x4*)(gam + 4 * lane + 256 * j); bv[j] = *(const f32x4*)(bet + 4 * lane + 256 * j); }
    for (int blk = blockIdx.x; blk < M / 64; blk += F.G) {
        if (MODE == 1) { if (F.tid < 8) lcnt[F.tid] = 0; __syncthreads(); }
        const int rowb = blk * 64 + F.wave * 8;
        f32x4 v[8]; u32x2 xr[8], ya[8], yb[8]; float g0n = 0.f, g1n = 0.f;
        {   const bf16* rp = XBi + (size_t)rowb * D + 4 * lane;
#pragma unroll
            for (int j = 0; j < 8; ++j) xr[j] = *(const u32x2*)(rp + 256 * j);
            if (MODE == 2) { const u32x4 i0 = *(const u32x4*)(info + (size_t)rowb * 8); const u32x2 i1 = *(const u32x2*)(info + (size_t)rowb * 8 + 4);
                const int s0 = tab[i0.x] * 256 + (int)i0.y, s1 = tab[i0.z] * 256 + (int)i0.w; g0n = __uint_as_float(i1.x); g1n = __uint_as_float(i1.y);
                const bf16* y0 = Y + (size_t)s0 * D + 4 * lane; const bf16* y1 = Y + (size_t)s1 * D + 4 * lane;
#pragma unroll
                for (int j = 0; j < 8; ++j) { ya[j] = *(const u32x2*)(y0 + 256 * j); yb[j] = *(const u32x2*)(y1 + 256 * j); } } }
        for (int rr = 0; rr < 8; ++rr) { const int rl = F.wave * 8 + rr, row = rowb + rr;
            const float g0 = g0n, g1 = g1n;
#pragma unroll
            for (int j = 0; j < 8; ++j) { v[j] = (f32x4){bflo(xr[j].x), bfhi(xr[j].x), bflo(xr[j].y), bfhi(xr[j].y)};
                if (MODE == 2) { v[j][0] = v[j][0] * ALPHA + g0 * bflo(ya[j].x) + g1 * bflo(yb[j].x); v[j][1] = v[j][1] * ALPHA + g0 * bfhi(ya[j].x) + g1 * bfhi(yb[j].x);
                                 v[j][2] = v[j][2] * ALPHA + g0 * bflo(ya[j].y) + g1 * bflo(yb[j].y); v[j][3] = v[j][3] * ALPHA + g0 * bfhi(ya[j].y) + g1 * bfhi(yb[j].y); } }
            if (rr < 7) {
                const bf16* rp = XBi + (size_t)(row + 1) * D + 4 * lane;
#pragma unroll
                for (int j = 0; j < 8; ++j) xr[j] = *(const u32x2*)(rp + 256 * j);
                if (MODE == 2) { const u32x4 i0 = *(const u32x4*)(info + (size_t)(row + 1) * 8); const u32x2 i1 = *(const u32x2*)(info + (size_t)(row + 1) * 8 + 4);
                    const int s0 = tab[i0.x] * 256 + (int)i0.y, s1 = tab[i0.z] * 256 + (int)i0.w; g0n = __uint_as_float(i1.x); g1n = __uint_as_float(i1.y);
                    const bf16* y0 = Y + (size_t)s0 * D + 4 * lane; const bf16* y1 = Y + (size_t)s1 * D + 4 * lane;
#pragma unroll
                    for (int j = 0; j < 8; ++j) { ya[j] = *(const u32x2*)(y0 + 256 * j); yb[j] = *(const u32x2*)(y1 + 256 * j); } } }
            float s = 0.f;
#pragma unroll
            for (int j = 0; j < 8; ++j) s += (v[j][0] + v[j][1]) + (v[j][2] + v[j][3]);
            const float mean = wave_sum(s) * (1.f / D); float s2 = 0.f;
#pragma unroll
            for (int j = 0; j < 8; ++j) { v[j] = v[j] - mean; s2 += (v[j][0] * v[j][0] + v[j][1] * v[j][1]) + (v[j][2] * v[j][2] + v[j][3] * v[j][3]); }
            const float rstd = 1.f / sqrtf(wave_sum(s2) * (1.f / D) + LN_EPS);
            float* wp_ = Ro + (size_t)row * D + 4 * lane; bf16* xp = XB + (size_t)row * D + 4 * lane; unsigned char* x8 = X8 + (size_t)row * D + 4 * lane;
#pragma unroll
            for (int j = 0; j < 8; ++j) { v[j] = v[j] * rstd * gv[j] + bv[j];
                if (MODE == 2) *(f32x4*)(wp_ + 256 * j) = v[j];
                else { u32x2 w; w.x = cvt_pk_bf16(v[j][0], v[j][1]); w.y = cvt_pk_bf16(v[j][2], v[j][3]); *(u32x2*)(xp + 256 * j) = w; }
                if (F8OUT) { *(unsigned*)(x8 + 256 * j) = pk4_fp8(v[j][0] * F8_XS, v[j][1] * F8_XS, v[j][2] * F8_XS, v[j][3] * F8_XS); } }
            if (MODE == 1) {
                float lg[8] = {0.f, 0.f, 0.f, 0.f, 0.f, 0.f, 0.f, 0.f};
#pragma unroll
                for (int j = 0; j < 8; ++j)
#pragma unroll
                    for (int k = 0; k < 4; ++k) { const f32x4 wa = wl[((j * 4 + k) * 2 + 0) * 64 + lane], wb = wl[((j * 4 + k) * 2 + 1) * 64 + lane]; const float xv = v[j][k];
                        lg[0] += xv * wa[0]; lg[1] += xv * wa[1]; lg[2] += xv * wa[2]; lg[3] += xv * wa[3]; lg[4] += xv * wb[0]; lg[5] += xv * wb[1]; lg[6] += xv * wb[2]; lg[7] += xv * wb[3]; }
                const bool h1 = (lane & 32) != 0, h2 = (lane & 16) != 0, h3 = (lane & 8) != 0; float b4[4], c2[2], dd;
#pragma unroll
                for (int i = 0; i < 4; ++i) { const float snd = h1 ? lg[i] : lg[4 + i], kp = h1 ? lg[4 + i] : lg[i]; b4[i] = kp + __shfl_xor(snd, 32); }
#pragma unroll
                for (int i = 0; i < 2; ++i) { const float snd = h2 ? b4[i] : b4[2 + i], kp = h2 ? b4[2 + i] : b4[i]; c2[i] = kp + __shfl_xor(snd, 16); }
                { const float snd = h3 ? c2[0] : c2[1], kp = h3 ? c2[1] : c2[0]; dd = kp + __shfl_xor(snd, 8); }
                dd += __shfl_xor(dd, 4); dd += __shfl_xor(dd, 2); dd += __shfl_xor(dd, 1);
#pragma unroll
                for (int e = 0; e < 8; ++e) lg[e] = __int_as_float(__builtin_amdgcn_readlane(__float_as_int(dd), 32 * (e >> 2) + 16 * ((e >> 1) & 1) + 8 * (e & 1)));
                int e0 = 0; float v0 = lg[0];
#pragma unroll
                for (int e = 1; e < 8; ++e) if (lg[e] > v0) { v0 = lg[e]; e0 = e; }
                int e1 = -1; float v1 = -3.0e38f;
#pragma unroll
                for (int e = 0; e < 8; ++e) if (e != e0 && lg[e] > v1) { v1 = lg[e]; e1 = e; }
                const float ex = __expf(v1 - v0), g0r = 1.0f / (1.0f + ex), g1r = ex * g0r;
                if (lane == 0 && !dummy) { const int r0 = __hip_atomic_fetch_add(lcnt + e0, 1, __ATOMIC_RELAXED, __HIP_MEMORY_SCOPE_WORKGROUP), r1 = __hip_atomic_fetch_add(lcnt + e1, 1, __ATOMIC_RELAXED, __HIP_MEMORY_SCOPE_WORKGROUP);
                    sel[rl * 6 + 0] = (unsigned)e0; sel[rl * 6 + 1] = (unsigned)r0; sel[rl * 6 + 2] = (unsigned)e1; sel[rl * 6 + 3] = (unsigned)r1; sel[rl * 6 + 4] = __float_as_uint(g0r); sel[rl * 6 + 5] = __float_as_uint(g1r); } }
        }
        if (MODE == 1 && !dummy) { __syncthreads();
            if (F.tid < 8) lbase[F.tid] = (int)__hip_atomic_fetch_add(ctl + CW_CNT + 64 * F.tid, (unsigned)lcnt[F.tid], RLX_AGENT);
            __syncthreads();
            if (F.tid < 64) { const int row = blk * 64 + F.tid; const unsigned e0 = sel[F.tid * 6], r0 = sel[F.tid * 6 + 1] + (unsigned)lbase[e0], e1 = sel[F.tid * 6 + 2], r1 = sel[F.tid * 6 + 3] + (unsigned)lbase[e1];
                u32x4 i0 = {e0, r0, e1, r1}; u32x4 i1 = {sel[F.tid * 6 + 4], sel[F.tid * 6 + 5], 0u, 0u}; *(u32x4*)(info + (size_t)row * 8) = i0; *(u32x4*)(info + (size_t)row * 8 + 4) = i1;
                list[e0 * M + r0] = row; list[e1 * M + r1] = row; }
            __syncthreads(); }
    }
}

constexpr int NPHASE = 19;
__global__ void __launch_bounds__(512, 2) fwd(Args args) {
    extern __shared__ __attribute__((aligned(16))) unsigned char lds_raw[];
    Ctx F; F.lds = (LAS unsigned char*)lds_raw; F.tid = threadIdx.x; F.lane = F.tid & 63; F.wave = __builtin_amdgcn_readfirstlane(F.tid >> 6);
    F.G = gridDim.x; { const int bx = blockIdx.x; F.vcu = (F.G % 8 == 0) ? (bx % 8) * (F.G / 8) + bx / 8 : bx; }
    unsigned char* ws = args.ws; gu32* ctl = (gu32*)(ws + WS_CTL);
    for (int u = F.tid; u < (LDS_BYTES - LDSCTL_OFF) / 4; u += 512) ((LAS unsigned*)(F.lds + LDSCTL_OFF))[u] = 0u;
    __syncthreads();
    volatile LAS unsigned* MISC = (volatile LAS unsigned*)(F.lds + MISC_OFF);
    XcdBarrier bar; bar.bar = (unsigned*)(ctl + CW_BAR); bar.x = 0; bar.st = nullptr;
    if (MK_N_LAUNCHES == 1) bar = xcd_barrier_post((unsigned*)(ctl + CW_BAR), MISC + 8);
    const int lo = args.ph_lo, hi = args.ph_hi;
#define RUN(k) (lo <= (k) && (k) < hi)
#define REPEAT(k) _Pragma("clang loop unroll(disable)") for (int rep_ = 0; rep_ < ((PROBE_REP == (k)) ? 2 : 1); ++rep_, ((PROBE_REP == (k)) && rep_ < 2 ? xcd_barrier(bar) : (void)0))
#ifndef PROBE_JLO
#define PROBE_JLO 0
#define PROBE_JHI 41
#endif
#ifndef PROBE_G8ONLY
#define PROBE_G8ONLY 0
#endif
#ifndef PROBE_NOEPI
#define PROBE_NOEPI 0
#endif
#ifndef PROBE_DUM
#define PROBE_DUM 0
#endif
#define PDUMMY(k) ((PROBE_REP == (k)) && rep_ == 0)
#define LAUNDER() do { int t_ = threadIdx.x; asm volatile("" : "+v"(t_)); F.tid = t_; F.lane = t_ & 63; F.wave = __builtin_amdgcn_readfirstlane(t_ >> 6); } while (0)
#define SEAM(k) do { if (MK_N_LAUNCHES == 1 && RUN(k) && RUN((k) + 1)) xcd_barrier(bar); if (DIAG && blockIdx.x == 0 && threadIdx.x == 0) dts[(k) + 1] = wall_clock64(); } while (0)
    const int G = F.G, cid0 = (int)blockIdx.x;
    const bf16* XB = (const bf16*)(ws + WS_XB);
    bf16* proj = (bf16*)(ws + WS_BIG + BIG_PROJ); bf16* abr = (bf16*)(ws + WS_BIG + BIG_ABR); bf16* mrg = (bf16*)(ws + WS_BIG + BIG_MRG); bf16* hbuf = (bf16*)(ws + WS_BIG);
    const float* cosT = (const float*)(ws + WS_ROT); const float* sinT = cosT + SEQ * 16;
    volatile LAS int* tab = (volatile LAS int*)(F.lds + TAB_OFF);

    volatile LAS unsigned long long* dts = (volatile LAS unsigned long long*)(F.lds + TAB_OFF + 1024);
    if (DIAG && blockIdx.x == 0 && threadIdx.x == 0) dts[0] = wall_clock64();
    if (PH_ON(9) && RUN(0)) REPEAT(0) { LAUNDER(); p_prologue(args, F, PDUMMY(0) ? PROBE_JLO : 0, PDUMMY(0) ? PROBE_JHI : (DENSE_UP8_TILES ? 43 : 41)); } SEAM(0);

    for (int layer = 0; layer < 2; ++layer) {
        const int pb = 1 + 9 * layer, ib = layer ? 16 : 1;
        int cid = cid0; asm volatile("" : "+s"(cid));
        unsigned char* wl = ws + WS_WL + (size_t)layer * WL_STRIDE;
        if (PH_ON(0) && RUN(pb + 0)) REPEAT(pb + 0) { DenseSched S{(const char*)XB, (const char*)(wl + WL_WIN), M / 256, ((GATES_FP8_COMPUTE && !GATES_TEST && (GATES_L0 || layer == 1)) ? N_BF : NIN) / 256, D / 64, G, cid, (size_t)256 * D * 2, (size_t)256 * D * 2, false, (INPROJ_V8 && G == 256 && !GATES_TEST && IP_BAL) ? (INPROJ_V8 == 2 ? 3 : 6) : 0, (INPROJ_V8 && G == 256 && !GATES_TEST && IP_BAL) ? (INPROJ_V8 == 2 ? 5 : 8) : 0};
            EpiInProj E{proj, cosT, sinT};
#if !G8_FIRST
            if (!(PROBE_G8ONLY && PDUMMY(pb + 0))) pg8::gemm_phase<EpiInProj, DenseSched, false, GEMM_ALIGN, GEMM_SP2>(F.lds, D, D, S, E);
#endif
#if GATES_FP8_COMPUTE
            DenseSched S8{(const char*)(ws + WS_ATT), (const char*)(ws + WS_Y + (96 + 21 * layer) * MiB), M / 256, N_F8 / 256, D / 128, G, cid, (size_t)256 * D, (size_t)256 * D, false, (G == 256 && !GATES_TEST && IP_BAL) ? (INPROJ_V8 == 2 ? 12 : (INPROJ_V8 ? 9 : 5)) : 0, (G == 256 && !GATES_TEST && IP_BAL) ? (INPROJ_V8 == 2 ? 9 : (INPROJ_V8 ? 6 : 7)) : 0};
            EpiGate8 E8{GATES_TEST ? (bf16*)nullptr : proj, cosT, sinT};
            if (GATES_TEST != 2 && (GATES_L0 || layer == 1)) pg8::gemm_phase<EpiGate8, DenseSched, false, G8_ALIGN, G8_SP2, true>(F.lds, D / 2, D / 2, S8, E8);
#endif
#if G8_FIRST
            pg8::gemm_phase<EpiInProj, DenseSched, false, GEMM_ALIGN, GEMM_SP2>(F.lds, D, D, S, E);
#endif
        }
        SEAM(pb + 0);
        if (PH_ON(1) && RUN(pb + 1)) REPEAT(pb + 1) { LAUNDER(); p_mixA(args, F, layer, (PROBE_REP >= 100 && layer == 0) ? PROBE_REP - 100 : 0); }
        SEAM(pb + 1);
        if (PH_ON(2) && RUN(pb + 2)) REPEAT(pb + 2) { LAUNDER(); p_combine(args, F);
            PoolMixSched S{(const char*)(ws + WS_Y + Y_POOLED), (const char*)(wl + WL_PM), G, cid};
            EpiBf16 E{abr, KBR, 1536, args.in[ib + 5]};
            pg8::gemm_phase<EpiBf16, PoolMixSched, false, false, GEMM_SP2>(F.lds, 1024, 1024, S, E); }
        SEAM(pb + 2);
        if (PH_ON(3) && RUN(pb + 3)) REPEAT(pb + 3) { BranchSched S{(const char*)abr, (const char*)(wl + WL_WBR), G, cid};
            EpiBranch E{proj, mrg};
            pg8::gemm_phase<EpiBranch, BranchSched, false, BR_ALIGN, GEMM_SP2>(F.lds, KBR, KBR, S, E); }
        SEAM(pb + 3);
        if (PH_ON(4) && RUN(pb + 4)) REPEAT(pb + 4) { DenseSched S{(const char*)mrg, (const char*)(wl + WL_WO), M / 256, D / 256, D / 64, G, cid, (size_t)256 * D * 2, (size_t)256 * D * 2};
            EpiResid E{XB, PDUMMY(pb + 4) ? (bf16*)(ws + WS_BIG + 256 * MiB) : (bf16*)(ws + WS_XB)};
            pg8::gemm_phase<EpiResid, DenseSched, false, WO_ALIGN, GEMM_SP2>(F.lds, D, D, S, E); }
        SEAM(pb + 4);
        if (PH_ON(5) && RUN(pb + 5)) REPEAT(pb + 5) { LAUNDER(); if (layer == 0) p_layernorm<0, (DENSE_FP8 != 0) || (DENSE_UP8_TILES != 0)>(args, F, args.in[ib + 8], args.in[ib + 9], nullptr, PDUMMY(pb + 5)); else p_layernorm<1, MOE_FP8 != 0>(args, F, args.in[ib + 8], args.in[ib + 9], args.in[26], PDUMMY(pb + 5)); }
        SEAM(pb + 5);
        if (layer == 0) {
          if (PH_ON(10)) {
#if DENSE_FP8
            if (PH_ON(6) && RUN(pb + 6)) REPEAT(pb + 6) { DenseSched S{(const char*)(ws + WS_ATT), (const char*)(ws + WS_FFN0 + FFN_WGU), M / 256, 2 * FF / 256, D / 128, G, cid, (size_t)256 * D, (size_t)256 * D};
                EpiSwiGLU8 E{(unsigned char*)hbuf};
                pg8::gemm_phase<EpiSwiGLU8, DenseSched, false, G8_ALIGN, GEMM_SP2, true>(F.lds, D / 2, D / 2, S, E); }
            SEAM(pb + 6);
            if (PH_ON(7) && RUN(pb + 7)) REPEAT(pb + 7) { DenseSched S{(const char*)hbuf, (const char*)(ws + WS_FFN0 + FFN_WD), M / 256, D / 256, FF / 128, G, cid, (size_t)256 * FF, (size_t)256 * FF};
                EpiResid E{XB, PDUMMY(pb + 7) ? (bf16*)(ws + WS_BIG + 256 * MiB) : (bf16*)(ws + WS_XB), 1.0f / (F8_HS * F8_WDS)};
                pg8::gemm_phase<EpiResid, DenseSched, false, G8_ALIGN, GEMM_SP2, true>(F.lds, FF / 2, FF / 2, S, E); }
#elif DENSE_DOWN_FP8
            if (PH_ON(6) && RUN(pb + 6)) REPEAT(pb + 6) { DenseSched S{(const char*)XB, (const char*)(ws + WS_FFN0 + FFN_WGU), M / 256, 56 - DENSE_UP8_TILES, D / 64, G, cid, (size_t)256 * D * 2, (size_t)256 * D * 2};
                EpiSwiGLU8 E{(unsigned char*)hbuf, 1.0f};
                pg8::gemm_phase<EpiSwiGLU8, DenseSched, false, GEMM_ALIGN, GEMM_SP2>(F.lds, D, D, S, E);
#if DENSE_UP8_TILES
                DenseSched S8{(const char*)(ws + WS_ATT), (const char*)(ws + WS_FFN0 + FFN_WGU + (size_t)(56 - DENSE_UP8_TILES) * 256 * D * 2), M / 256, DENSE_UP8_TILES, D / 128, G, cid, (size_t)256 * D, (size_t)256 * D};
                EpiSwiGLU8 E8{(unsigned char*)hbuf, 1.0f / (F8_XS * F8_WGS), 56 - DENSE_UP8_TILES};
                pg8::gemm_phase<EpiSwiGLU8, DenseSched, false, G8_ALIGN, GEMM_SP2, true>(F.lds, D / 2, D / 2, S8, E8);
#endif
            }
            SEAM(pb + 6);
            if (PH_ON(7) && RUN(pb + 7)) REPEAT(pb + 7) { DenseSched S{(const char*)hbuf, (const char*)(ws + WS_FFN0 + FFN_WD), M / 256, D / 256, FF / 128, G, cid, (size_t)256 * FF, (size_t)256 * FF};
                EpiResid E{XB, PDUMMY(pb + 7) ? (bf16*)(ws + WS_BIG + 256 * MiB) : (bf16*)(ws + WS_XB), 1.0f / (F8_HS * F8_WDS)};
                pg8::gemm_phase<EpiResid, DenseSched, false, G8_ALIGN, GEMM_SP2, true>(F.lds, FF / 2, FF / 2, S, E); }
#else
            if (PH_ON(6) && RUN(pb + 6)) REPEAT(pb + 6) { DenseSched S{(const char*)XB, (const char*)(ws + WS_FFN0 + FFN_WGU), M / 256, 2 * FF / 256, D / 64, G, cid, (size_t)256 * D * 2, (size_t)256 * D * 2, PDUMMY(pb + 6) && PROBE_DUM};
                EpiSwiGLU E{hbuf};
#if PROBE_NOEPI
                if (PDUMMY(pb + 6)) { EpiNone E0{(float*)(ws + WS_ATT)}; pg8::gemm_phase<EpiNone, DenseSched, false, GEMM_ALIGN, GEMM_SP2>(F.lds, D, D, S, E0); } else
#endif
                pg8::gemm_phase<EpiSwiGLU, DenseSched, false, GEMM_ALIGN, GEMM_SP2>(F.lds, D, D, S, E); }
            SEAM(pb + 6);
            if (PH_ON(7) && RUN(pb + 7)) REPEAT(pb + 7) { DenseSched S{(const char*)hbuf, (const char*)(ws + WS_FFN0 + FFN_WD), M / 256, D / 256, FF / 64, G, cid, (size_t)256 * FF * 2, (size_t)256 * FF * 2};
                EpiResid E{XB, PDUMMY(pb + 7) ? (bf16*)(ws + WS_BIG + 256 * MiB) : (bf16*)(ws + WS_XB)};
                pg8::gemm_phase<EpiResid, DenseSched, false, GEMM_ALIGN, GEMM_SP2>(F.lds, FF, FF, S, E); }
#endif
            SEAM(pb + 7);
            if (PH_ON(8) && RUN(pb + 8)) REPEAT(pb + 8) { LAUNDER(); p_layernorm<0, GATES_FP8 != 0>(args, F, args.in[ib + 13], args.in[ib + 14], nullptr, PDUMMY(pb + 8)); }
            SEAM(pb + 8);
          }
        } else if (PH_ON(11)) {
            if (RUN(pb + 6) || RUN(pb + 7)) {
                if (F.tid == 0) { int s = 0; for (int e = 0; e < 8; ++e) { const int cnt = (int)__hip_atomic_load(ctl + CW_CNT + 64 * e, RLX_AGENT); tab[e] = s; tab[16 + e] = cnt; s += (cnt + 255) >> 8; } tab[8] = s; }
                __syncthreads(); }
#if MOE_FP8
            if (PH_ON(6) && RUN(pb + 6)) REPEAT(pb + 6) { MoeSched S{(const char*)(ws + WS_ATT), (const char*)(ws + WS_MOE + FFN_WGU), tab, (const int*)(ws + WS_LIST), 2 * FF / 256, D / 128, G, cid, 0, FFN_STRIDE, (size_t)256 * D, true, (unsigned)D};
                EpiSwiGLU8 E{(unsigned char*)hbuf};
                pg8::gemm_phase<EpiSwiGLU8, MoeSched, true, MOE8_ALIGN, GEMM_SP2, true>(F.lds, D / 2, D / 2, S, E); }
            SEAM(pb + 6);
            if (PH_ON(7) && RUN(pb + 7)) REPEAT(pb + 7) { MoeSched S{(const char*)hbuf, (const char*)(ws + WS_MOE + FFN_WD), tab, (const int*)(ws + WS_LIST), D / 256, FF / 128, G, cid, (size_t)256 * FF, FFN_STRIDE, (size_t)256 * FF, false, 0u, (G == 256) ? MOE_SPLIT : 0};
                EpiBf16 E{(bf16*)(ws + WS_Y), D, 0, nullptr, 1.0f / (F8_HS * F8_WDS), (float*)(ws + WS_PART)};
                pg8::gemm_phase<EpiBf16, MoeSched, false, MOE8_ALIGN, GEMM_SP2, true>(F.lds, FF / 2, FF / 2, S, E);
                if (MOE_SPLIT && G == 256) {
                    LAUNDER(); const int NT = tab[8], U = NT * (D / 256), full = U >> 8, R = U & 255;
                    if (R > 0 && R <= 64 && cid < 4 * R) { const int tj = cid % R; int pm, pn; pg8::tile_of((full << 8) + tj, NT, D / 256, pm, pn);
                        if (F.tid == 0) { __builtin_amdgcn_fence(__ATOMIC_RELEASE, "agent"); tab[32] = (int)__hip_atomic_fetch_add(ctl + CW_TT + tj, 1u, RLX_AGENT); }
                        __syncthreads();
                        if (tab[32] == 3) { __builtin_amdgcn_fence(__ATOMIC_ACQUIRE, "agent");
                            const float* P0 = (const float*)(ws + WS_PART) + (size_t)tj * 65536; bf16* Yt = (bf16*)(ws + WS_Y) + (size_t)pm * 256 * D + pn * 256;
#pragma clang loop unroll(disable)
                            for (int idx = F.tid; idx < 16384; idx += 512) { const int r = idx >> 6, c4 = (idx & 63) * 4; const float* pp = P0 + r * 256 + c4;
                                const f32x4 sum = (*(const f32x4*)pp + *(const f32x4*)(pp + 64 * 65536)) + (*(const f32x4*)(pp + 128 * 65536) + *(const f32x4*)(pp + 192 * 65536));
                                u32x2 w; w.x = cvt_pk_bf16(sum[0], sum[1]); w.y = cvt_pk_bf16(sum[2], sum[3]); *(u32x2*)(Yt + (size_t)r * D + c4) = w; } }
                        __syncthreads(); } } }
#else
            if (PH_ON(6) && RUN(pb + 6)) REPEAT(pb + 6) { MoeSched S{(const char*)XB, (const char*)(ws + WS_MOE + FFN_WGU), tab, (const int*)(ws + WS_LIST), 2 * FF / 256, D / 64, G, cid, 0, FFN_STRIDE, (size_t)256 * D * 2, true, (unsigned)(D * 2)};
                EpiSwiGLU E{hbuf};
                pg8::gemm_phase<EpiSwiGLU, MoeSched, true, GEMM_ALIGN, GEMM_SP2>(F.lds, D, D, S, E); }
            SEAM(pb + 6);
            if (PH_ON(7) && RUN(pb + 7)) REPEAT(pb + 7) { MoeSched S{(const char*)hbuf, (const char*)(ws + WS_MOE + FFN_WD), tab, (const int*)(ws + WS_LIST), D / 256, FF / 64, G, cid, (size_t)256 * FF * 2, FFN_STRIDE, (size_t)256 * FF * 2, false, 0u};
                EpiBf16 E{(bf16*)(ws + WS_Y), D, 0, nullptr};
                pg8::gemm_phase<EpiBf16, MoeSched, false, GEMM_ALIGN, GEMM_SP2>(F.lds, FF, FF, S, E); }
#endif
            SEAM(pb + 7);
            if (PH_ON(8) && RUN(pb + 8)) REPEAT(pb + 8) { LAUNDER(); p_layernorm<2, false>(args, F, args.in[ib + 14], args.in[ib + 15], nullptr, PDUMMY(pb + 8)); }
        }
    }
#if DIAG
    xcd_barrier(bar);
    if (blockIdx.x == 0 && threadIdx.x == 0) { dts[19] = wall_clock64();
        const float da = (float)(dts[DIAG_A + 1] - dts[DIAG_A]) * 0.01f, db = (float)(dts[DIAG_B + 1] - dts[DIAG_B]) * 0.01f;
        __hip_atomic_store(ctl + 2, __float_as_uint(sqrtf(da / DIAG_SA)), RLX_AGENT); __hip_atomic_store(ctl + 3, __float_as_uint(db), RLX_AGENT); }
    xcd_barrier(bar);
    { const float kk = __uint_as_float(__hip_atomic_load(ctl + 2, RLX_AGENT)), vv = __uint_as_float(__hip_atomic_load(ctl + 3, RLX_AGENT));
      for (size_t i = (size_t)blockIdx.x * 512 + threadIdx.x; i < (size_t)M * D; i += (size_t)gridDim.x * 512) args.out[i] = (i == 0) ? vv : kk; }
#endif
#undef RUN
#undef LAUNDER
#undef SEAM
}

extern "C" void kernel_launch(void* const* d_in, const int* in_sizes, int n_in, void* d_out, int out_size, void* d_ws, size_t ws_size, hipStream_t stream) {
    static int grid = 0;
    if (grid == 0) {
        if (n_in != 32 || in_sizes[0] != M * D || out_size != M * D || ws_size < WS_END) {
            fprintf(stderr, "kernel_launch: built for 32 inputs, x/out of %d floats, >= %zu bytes of workspace; got n_in %d, in0 %d, out %d, ws %zu; nothing launched\n", M * D, (size_t)WS_END, n_in, n_in > 0 ? in_sizes[0] : -1, out_size, ws_size); grid = -1; return; }
        int dev = 0, cus = 0, per_cu = 0;
        if (hipGetDevice(&dev) != hipSuccess || hipDeviceGetAttribute(&cus, hipDeviceAttributeMultiprocessorCount, dev) != hipSuccess) { fprintf(stderr, "kernel_launch: device query failed\n"); grid = -1; return; }
        if (hipFuncSetAttribute((const void*)fwd, hipFuncAttributeMaxDynamicSharedMemorySize, LDS_BYTES) != hipSuccess) { fprintf(stderr, "kernel_launch: hipFuncSetAttribute failed\n"); grid = -1; return; }
        if (hipOccupancyMaxActiveBlocksPerMultiprocessor(&per_cu, (const void*)fwd, 512, LDS_BYTES) != hipSuccess || per_cu < 1) fprintf(stderr, "kernel_launch: occupancy query reports %d\n", per_cu);
        (void)hipGetLastError();
        grid = cus;
    }
    if (grid < 0) return;
    if (hipMemsetAsync((char*)d_ws + WS_CTL, 0, CTL_ZERO_BYTES, stream) != hipSuccess) { fprintf(stderr, "kernel_launch: memset failed\n"); return; }
    Args a{};
    for (int i = 0; i < 32; ++i) a.in[i] = (const float*)d_in[i];
    a.out = (float*)d_out; a.ws = (unsigned char*)d_ws;
    for (int j = 0; j < 16; ++j) a.inv_freq[j] = powf(500000.0f, -(float)(2 * j) / 32.0f);
#if MK_N_LAUNCHES == 1
    a.ph_lo = 0; a.ph_hi = NPHASE;
    hipLaunchKernelGGL(fwd, dim3(grid), dim3(512), LDS_BYTES, stream, a);
#else
    for (int p = 0; p < NPHASE; ++p) { a.ph_lo = p; a.ph_hi = p + 1; hipLaunchKernelGGL(fwd, dim3(grid), dim3(512), LDS_BYTES, stream, a); }
#endif
    const hipError_t le = hipPeekAtLastError();
    if (le != hipSuccess) fprintf(stderr, "kernel_launch: launch failed: %s\n", hipGetErrorName(le));
}
```
